# Optimizing an MI355X kernel written in HIP

```python
import math
import jax, jax.numpy as jnp
from jax import lax
import numpy as np

D_MODEL = 2048
BATCH = 8
SEQ = 2048
DEPTH = 2
DEC_BATCH = 8
DEC_SEQ = 64
PAST_LEN = 4096

CHUNK = 64
Q_BLOCK = 128
D_R = D_MODEL // 2
DH_R = 128
H_R = D_R // DH_R
ROPE_BASE = 10000.0
D_DV = D_MODEL // 2
DH_V = 128
H_D = D_DV // DH_V
DH_QK = DH_V // 2
D_DQK = H_D * 2 * DH_QK
D_FF = 5632
N_BUCKETS = 32
MAX_DISTANCE = 128
EPS = 1e-6
N_PROJ = 4 * D_R + 2 * D_DQK + D_DV + 2 * D_MODEL

kernel_name = "hybrid_retention_diffattn_streaming_step"


def _split_points():
    widths = [D_R, D_R, D_R, D_R, D_DQK, D_DQK, D_DV, D_MODEL, D_MODEL]
    pts, acc = [], 0
    for w in widths[:-1]:
        acc += w
        pts.append(acc)
    return pts


def _rms(x):
    xf = x.astype(jnp.float32)
    return xf * lax.rsqrt(jnp.mean(xf * xf, axis=-1, keepdims=True) + EPS)


def rms_norm(x, g):
    return (_rms(x) * g.astype(jnp.float32)).astype(x.dtype)


def swiglu(x, w_gate, w_up, w_down):
    return (jax.nn.silu(x @ w_gate) * (x @ w_up)) @ w_down


def rotary(x, pos):
    half = x.shape[-1] // 2
    inv = ROPE_BASE ** (-jnp.arange(half, dtype=jnp.float32) / half)
    ang = pos.astype(jnp.float32)[:, None] * inv[None, :]
    cos = jnp.cos(ang)[None, :, None, :]
    sin = jnp.sin(ang)[None, :, None, :]
    x1, x2 = x[..., :half], x[..., half:]
    return jnp.concatenate([x1 * cos - x2 * sin, x1 * sin + x2 * cos], axis=-1)


def t5_bucket(rel):
    nb = N_BUCKETS // 2
    max_exact = nb // 2
    base = jnp.where(rel > 0, nb, 0)
    n = jnp.abs(rel)
    large = max_exact + (jnp.log(jnp.maximum(n, 1).astype(jnp.float32) / max_exact)
                         / math.log(MAX_DISTANCE / max_exact) * (nb - max_exact)).astype(jnp.int32)
    large = jnp.minimum(large, nb - 1)
    return base + jnp.where(n < max_exact, n, large)


def retention(q, k, v, s0, length):
    B, S, H, D = q.shape
    nc = S // length
    log_g = jnp.log(1.0 - 2.0 ** (-5.0 - jnp.arange(H, dtype=jnp.float32)))
    qc = q.reshape(B, nc, length, H, D)
    kc = k.reshape(B, nc, length, H, D)
    vc = v.reshape(B, nc, length, H, D)
    idx = jnp.arange(length, dtype=jnp.float32)
    dmat = jnp.exp(log_g[:, None, None] * jnp.abs(idx[:, None] - idx[None, :]))
    s = jnp.einsum('bnihd,bnjhd->bnhij', qc, kc) * dmat
    intra = jnp.einsum('bnhij,bnjhe->bnihe', s, vc)
    w_end = jnp.exp(log_g[None, :] * (length - 1 - idx)[:, None])
    kv = jnp.einsum('bnjhd,bnjhe->nbhde', kc * w_end[:, :, None], vc)
    decay_c = jnp.exp(log_g * length)[None, :, None, None]

    def step(s_prev, kv_n):
        return decay_c * s_prev + kv_n, s_prev

    s_final, s_before = lax.scan(step, s0, kv)
    w_q = jnp.exp(log_g[None, :] * (idx + 1.0)[:, None])
    inter = jnp.einsum('bnihd,nbhde->bnihe', qc * w_q[:, :, None], s_before)
    return (intra + inter).reshape(B, S, H, D), s_final


def diff_attend(q, k, v, qpos, kpos, lam, rel_bias):
    s = jnp.einsum('bqhcd,bkhcd->bchqk', q, k, preferred_element_type=jnp.float32) * (DH_QK ** -0.5)
    bias = jnp.transpose(rel_bias[t5_bucket(kpos[None, :] - qpos[:, None])], (2, 0, 1)).astype(jnp.float32)
    mask = (kpos[None, :] // CHUNK) <= (qpos[:, None] // CHUNK)
    s = jnp.where(mask, s + bias[None, None], -jnp.inf)
    p = jax.nn.softmax(s, axis=-1)
    a = p[:, 0] - lam * p[:, 1]
    return jnp.einsum('bhqk,bkhd->bqhd', a.astype(v.dtype), v)


def diff_prompt(q, k, v, pos, lam, rel_bias):
    B, S = q.shape[0], q.shape[1]
    nqb = S // Q_BLOCK
    qb = jnp.swapaxes(q.reshape(B, nqb, Q_BLOCK, H_D, 2, DH_QK), 0, 1)
    pb = pos.reshape(nqb, Q_BLOCK)
    out = lax.map(lambda a: diff_attend(a[0], k, v, a[1], pos, lam, rel_bias), (qb, pb))
    return jnp.swapaxes(out, 0, 1).reshape(B, S, H_D, DH_V)


def token_mix(h, pos, l, w_in, q_norm, k_norm, lambda_q1, lambda_k1, lambda_q2, lambda_k2,
              subln, w_ret_up, w_dif_up, w_out, rel_bias, s0, cache_k, cache_v):
    B, S, _ = h.shape
    f32 = jnp.float32
    proj = h @ w_in[l]
    rq, rk, rv, rg, dq, dk, dv, gr, gd = jnp.split(proj, _split_points(), axis=-1)
    rq = rotary(rq.reshape(B, S, H_R, DH_R).astype(f32), pos)
    rk = rotary(rk.reshape(B, S, H_R, DH_R).astype(f32), pos) * (DH_R ** -0.5)
    rv = rv.reshape(B, S, H_R, DH_R).astype(f32)
    length = CHUNK if cache_k is None else S
    ro, s_new = retention(rq, rk, rv, s0, length)
    ro = _rms(ro).reshape(B, S, D_R).astype(h.dtype) * jax.nn.silu(rg)
    y_a = ro @ w_ret_up[l]
    dq = rms_norm(dq.reshape(B, S, H_D, 2, DH_QK), q_norm[l])
    dk = rms_norm(dk.reshape(B, S, H_D, 2, DH_QK), k_norm[l])
    dv = dv.reshape(B, S, H_D, DH_V)
    lam_init = 0.8 - 0.6 * math.exp(-0.3 * l)
    lam = (jnp.exp(jnp.sum(lambda_q1[l].astype(f32) * lambda_k1[l].astype(f32)))
           - jnp.exp(jnp.sum(lambda_q2[l].astype(f32) * lambda_k2[l].astype(f32))) + lam_init)
    if cache_k is None:
        do = diff_prompt(dq, dk, dv, pos, lam, rel_bias)
    else:
        past = cache_k.shape[2]
        ck = cache_k[l].reshape(B, past, H_D, 2, DH_QK).astype(dk.dtype)
        k_all = jnp.concatenate([ck, dk], axis=1)
        v_all = jnp.concatenate([cache_v[l].astype(dv.dtype), dv], axis=1)
        kpos = jnp.arange(past + S, dtype=jnp.int32)
        do = diff_attend(dq, k_all, v_all, pos, kpos, lam, rel_bias)
    do = rms_norm(do, subln[l]) * (1.0 - lam_init)
    y_b = do.reshape(B, S, D_DV) @ w_dif_up[l]
    merged = jax.nn.sigmoid(gr) * y_a + jax.nn.sigmoid(gd) * y_b
    return merged @ w_out[l], dk.reshape(B, S, H_D, 2 * DH_QK), dv, s_new


def run_trunk(x, pos, s0_all, cache_k, cache_v, ffn1_norm, ffn1_gate, ffn1_up, ffn1_down, mix_norm,
              w_in, q_norm, k_norm, lambda_q1, lambda_k1, lambda_q2, lambda_k2, subln,
              w_ret_up, w_dif_up, w_out, ffn2_norm, ffn2_gate, ffn2_up, ffn2_down, rel_bias):
    ks, vs, ss = [], [], []
    for l in range(DEPTH):
        h = rms_norm(x, ffn1_norm[l])
        x = x + 0.5 * swiglu(h, ffn1_gate[l], ffn1_up[l], ffn1_down[l])
        h = rms_norm(x, mix_norm[l])
        y, k_new, v_new, s_new = token_mix(h, pos, l, w_in, q_norm, k_norm, lambda_q1, lambda_k1,
                                           lambda_q2, lambda_k2, subln, w_ret_up, w_dif_up, w_out,
                                           rel_bias, s0_all[l], cache_k, cache_v)
        x = x + y
        h = rms_norm(x, ffn2_norm[l])
        x = x + 0.5 * swiglu(h, ffn2_gate[l], ffn2_up[l], ffn2_down[l])
        ks.append(k_new)
        vs.append(v_new)
        ss.append(s_new)
    return x, jnp.stack(ks), jnp.stack(vs), jnp.stack(ss)


def setup_inputs(seed: int = 0) -> dict:
    key = jax.random.key(seed)
    ks = iter(jax.random.split(key, 40))

    def nrm(shape, scale):
        return jax.random.normal(next(ks), shape, jnp.float32) * scale

    def gain(shape):
        return 1.0 + nrm(shape, 0.02)

    return {
        "x_prompt": nrm((BATCH, SEQ, D_MODEL), 1.0),
        "x_sample": nrm((DEC_BATCH, DEC_SEQ, D_MODEL), 1.0),
        "cache_diff_k": nrm((DEPTH, DEC_BATCH, PAST_LEN, H_D, 2 * DH_QK), 1.0),
        "cache_diff_v": nrm((DEPTH, DEC_BATCH, PAST_LEN, H_D, DH_V), 1.0),
        "state_ret": nrm((DEPTH, DEC_BATCH, H_R, DH_R, DH_R), 0.1),
        "ffn1_norm": gain((DEPTH, D_MODEL)),
        "ffn1_gate": nrm((DEPTH, D_MODEL, D_FF), D_MODEL ** -0.5),
        "ffn1_up": nrm((DEPTH, D_MODEL, D_FF), D_MODEL ** -0.5),
        "ffn1_down": nrm((DEPTH, D_FF, D_MODEL), D_FF ** -0.5),
        "mix_norm": gain((DEPTH, D_MODEL)),
        "w_in": nrm((DEPTH, D_MODEL, N_PROJ), D_MODEL ** -0.5),
        "q_norm": gain((DEPTH, DH_QK)),
        "k_norm": gain((DEPTH, DH_QK)),
        "lambda_q1": nrm((DEPTH, DH_QK), 0.1),
        "lambda_k1": nrm((DEPTH, DH_QK), 0.1),
        "lambda_q2": nrm((DEPTH, DH_QK), 0.1),
        "lambda_k2": nrm((DEPTH, DH_QK), 0.1),
        "subln": gain((DEPTH, DH_V)),
        "w_ret_up": nrm((DEPTH, D_R, D_MODEL), D_R ** -0.5),
        "w_dif_up": nrm((DEPTH, D_DV, D_MODEL), D_DV ** -0.5),
        "w_out": nrm((DEPTH, D_MODEL, D_MODEL), D_MODEL ** -0.5),
        "ffn2_norm": gain((DEPTH, D_MODEL)),
        "ffn2_gate": nrm((DEPTH, D_MODEL, D_FF), D_MODEL ** -0.5),
        "ffn2_up": nrm((DEPTH, D_MODEL, D_FF), D_MODEL ** -0.5),
        "ffn2_down": nrm((DEPTH, D_FF, D_MODEL), D_FF ** -0.5),
        "rel_bias": nrm((N_BUCKETS, H_D), 0.1),
    }


def reference(x_prompt, x_sample, cache_diff_k, cache_diff_v, state_ret, ffn1_norm, ffn1_gate, ffn1_up,
              ffn1_down, mix_norm, w_in, q_norm, k_norm, lambda_q1, lambda_k1, lambda_q2, lambda_k2, subln,
              w_ret_up, w_dif_up, w_out, ffn2_norm, ffn2_gate, ffn2_up, ffn2_down, rel_bias):
    weights = (ffn1_norm, ffn1_gate, ffn1_up, ffn1_down, mix_norm, w_in, q_norm, k_norm,
               lambda_q1, lambda_k1, lambda_q2, lambda_k2, subln, w_ret_up, w_dif_up, w_out,
               ffn2_norm, ffn2_gate, ffn2_up, ffn2_down, rel_bias)
    b, s = x_prompt.shape[0], x_prompt.shape[1]
    pos_p = jnp.arange(s, dtype=jnp.int32)
    s0_p = jnp.zeros((DEPTH, b, H_R, DH_R, DH_R), jnp.float32)
    y_prompt, k_p, v_p, st_p = run_trunk(x_prompt, pos_p, s0_p, None, None, *weights)
    past = cache_diff_k.shape[2]
    pos_s = past + jnp.arange(x_sample.shape[1], dtype=jnp.int32)
    y_sample, k_s, v_s, st_s = run_trunk(x_sample, pos_s, state_ret.astype(jnp.float32),
                                         cache_diff_k, cache_diff_v, *weights)
    return (y_prompt, y_sample,
            k_p.astype(cache_diff_k.dtype), v_p.astype(cache_diff_v.dtype), st_p.astype(state_ret.dtype),
            k_s.astype(cache_diff_k.dtype), v_s.astype(cache_diff_v.dtype), st_s.astype(state_ret.dtype))
```

```cpp
#include <hip/hip_runtime.h>
#include <cstdio>
#include <cstdint>

constexpr int DM = 2048, T_P = 16384, T_S = 512, TT = 16896, DFF = 5632, NPROJ = 11264, DEPTH = 2;
constexpr int SEQ = 2048, DSEQ = 64, PAST = 4096, NB = 8, NH = 8;
constexpr float EPS = 1e-6f;
constexpr float LOG2E = 1.4426950408889634f;
constexpr float QSCALE = 0.125f * LOG2E;
constexpr float RK_SCALE = 0.08838834764831845f;
namespace pg8 {
#define PG8_LAS __attribute__((address_space(3)))
typedef unsigned short bf16_t;
typedef short bf16x8 __attribute__((ext_vector_type(8)));
typedef float f32x4 __attribute__((ext_vector_type(4)));
typedef unsigned u32x4 __attribute__((ext_vector_type(4)));
constexpr int BM = 256, BK = 64, HALF = 128, HTB = HALF * BK * 2  , STAGE_BYTES = 8 * HTB, NXCD = 8, WGM = 8;

__host__ __device__ __forceinline__ int lds_byte(int r, int c) { const int st = (r >> 4) * 2 + (c >> 5), rr = r & 15, cc = c & 31, ob = rr * 64 + cc * 2; return st * 1024 + (ob ^ (((ob >> 9) & 1) << 5)); }
__host__ __device__ __forceinline__ void stage_rc(int b, int& R, int& C) { const int st = b / 1024, sb = b % 1024, swz = sb ^ (((sb >> 9) & 1) << 5); R = (st >> 1) * 16 + swz / 64; C = (st & 1) * 32 + (swz % 64) / 2; }
__host__ __device__ __forceinline__ int perm32(int rho) { const int n = rho >> 4, i = rho & 15; return 8 * (i >> 2) + 4 * n + (i & 3); }

struct Unit { int pm, pn; };
struct Gemm { const bf16_t* A; const bf16_t* Bt; int M, N, K; };

struct StaticOrder {
    int nM, nN, nwg, G, c;
    __host__ __device__ void init(int M, int N, int G_, int c_) { nM = M / BM; nN = N / BM; nwg = nM * nN; G = G_; c = c_; }
    __host__ __device__ bool next(int i, Unit& u) const {
        const long L = (long)i * G + c; if (L >= nwg) return false;
        int wgid = (int)L; { const int q = nwg / NXCD, r = nwg % NXCD, xcd = wgid % NXCD, off = wgid / NXCD; wgid = (xcd < r ? xcd * (q + 1) : r * (q + 1) + (xcd - r) * q) + off; }
        const int nig = WGM * nN, gid = wgid / nig, fm = gid * WGM, gsz = (nM - fm) < WGM ? (nM - fm) : WGM;
        u.pm = fm + ((wgid % nig) % gsz); u.pn = (wgid % nig) / gsz; return true;
    }
    __device__ __forceinline__ void a_ready(const Unit&) const {}
    __device__ __forceinline__ void done(const Unit&) const {}
};

__device__ __forceinline__ unsigned cvt_pk_bf16(float lo, float hi) { unsigned r; asm volatile("v_cvt_pk_bf16_f32 %0, %1, %2" : "=v"(r) : "v"(lo), "v"(hi)); return r; }
typedef float f32x2 __attribute__((ext_vector_type(2)));
typedef unsigned u32x2 __attribute__((ext_vector_type(2)));
__device__ __forceinline__ float silu_f(float x) { return x * __builtin_amdgcn_rcpf(1.0f + __builtin_amdgcn_exp2f(-x * 1.4426950408889634f)); }
__device__ __forceinline__ float sigm_f(float x) { return __builtin_amdgcn_rcpf(1.0f + __builtin_amdgcn_exp2f(-x * 1.4426950408889634f)); }
__device__ __forceinline__ float rinv_of(const float* ss, int row) { return rsqrtf(ss[row] * (1.0f / 2048.0f) + 1e-6f); }

struct EpiSwiglu {
    static constexpr bool PERM = true, AFTER_DRAIN = false;
    bf16_t* H; const float* ss;
    __device__ __forceinline__ void operator()(const f32x4 (&acc)[2][2][4][2], const Unit& u, int wr, int wc, int fr, int fq) const {
        const int row0 = u.pm * BM + wr * 64 + fr, col0 = u.pn * 128 + wc * 32 + 8 * fq;
#pragma unroll
        for (int ai = 0; ai < 2; ++ai)
#pragma unroll
            for (int m = 0; m < 4; ++m) { const int row = row0 + ai * HALF + m * 16; const float r = rinv_of(ss, row);
                float o[8];
#pragma unroll
                for (int n = 0; n < 2; ++n)
#pragma unroll
                    for (int e = 0; e < 4; ++e) { const float g = acc[ai][0][m][n][e] * r, up = acc[ai][1][m][n][e] * r; o[4 * n + e] = silu_f(g) * up; }
                u32x4 w; w.x = cvt_pk_bf16(o[0], o[1]); w.y = cvt_pk_bf16(o[2], o[3]); w.z = cvt_pk_bf16(o[4], o[5]); w.w = cvt_pk_bf16(o[6], o[7]);
                *(u32x4*)(H + (size_t)row * 5632 + col0) = w; }
    }
};

struct EpiResid {
    static constexpr bool PERM = false, AFTER_DRAIN = false;
    const float* baseP; const float* baseS; float* Y; bf16_t* XB; float* ssn; float alpha;
    __device__ __forceinline__ void operator()(const f32x4 (&acc)[2][2][4][2], const Unit& u, int wr, int wc, int fr, int fq) const {
        const int row0 = u.pm * BM + wr * 64 + fr, col0 = u.pn * BM + wc * 32 + 4 * fq;
        const float* base = (u.pm < 64) ? baseP : baseS;
#pragma unroll
        for (int ai = 0; ai < 2; ++ai)
#pragma unroll
            for (int m = 0; m < 4; ++m) { const int row = row0 + ai * HALF + m * 16; const size_t off = (size_t)row * 2048 + col0; float sq = 0.f;
#pragma unroll
                for (int bj = 0; bj < 2; ++bj)
#pragma unroll
                    for (int n = 0; n < 2; ++n) { const f32x4 b = *(const f32x4*)(base + off + bj * HALF + n * 16); const f32x4 o = b + acc[ai][bj][m][n] * alpha;
                        *(f32x4*)(Y + off + bj * HALF + n * 16) = o; sq += (o[0] * o[0] + o[1] * o[1]) + (o[2] * o[2] + o[3] * o[3]);
                        u32x2 w; w.x = cvt_pk_bf16(o[0], o[1]); w.y = cvt_pk_bf16(o[2], o[3]); *(u32x2*)(XB + off + bj * HALF + n * 16) = w; }
                sq += __shfl_xor(sq, 16); sq += __shfl_xor(sq, 32);
                if (fq == 0) unsafeAtomicAdd(ssn + row, sq); }
    }
};

template <int PASS> struct EpiGate {
    static constexpr bool PERM = true, AFTER_DRAIN = false;
    const bf16_t* G; bf16_t* MRG;
    __device__ __forceinline__ void operator()(const f32x4 (&acc)[2][2][4][2], const Unit& u, int wr, int wc, int fr, int fq) const {
        const int row0 = u.pm * BM + wr * 64 + fr, col0 = u.pn * BM + wc * 32 + 8 * fq;
#pragma unroll
        for (int ai = 0; ai < 2; ++ai)
#pragma unroll
            for (int m = 0; m < 4; ++m) { const size_t off = (size_t)(row0 + ai * HALF + m * 16) * 2048 + col0;
#pragma unroll
                for (int bj = 0; bj < 2; ++bj) { const u32x4 g = *(const u32x4*)(G + off + bj * HALF); u32x4 p = (u32x4){0u, 0u, 0u, 0u}; if (PASS == 1) p = *(const u32x4*)(MRG + off + bj * HALF);
                    float o[8];
#pragma unroll
                    for (int q = 0; q < 4; ++q) { const float g0 = __uint_as_float(g[q] << 16), g1 = __uint_as_float(g[q] & 0xffff0000u), p0 = __uint_as_float(p[q] << 16), p1 = __uint_as_float(p[q] & 0xffff0000u);
                        const f32x4 a = acc[ai][bj][m][q >> 1]; o[2 * q] = p0 + g0 * a[(2 * q) & 3]; o[2 * q + 1] = p1 + g1 * a[(2 * q + 1) & 3]; }
                    u32x4 w; w.x = cvt_pk_bf16(o[0], o[1]); w.y = cvt_pk_bf16(o[2], o[3]); w.z = cvt_pk_bf16(o[4], o[5]); w.w = cvt_pk_bf16(o[6], o[7]);
                    *(u32x4*)(MRG + off + bj * HALF) = w; } }
    }
};

struct EpiProj {
    static constexpr bool PERM = true, AFTER_DRAIN = false;
    const float* ss; const float* rot;
    const float* qg; const float* kg;
    bf16_t *RQ, *RK, *RV, *RG, *DQ, *DK, *DV, *GR, *GD;
    float *KP, *VP, *KS, *VS;
    __device__ __forceinline__ void operator()(const f32x4 (&acc)[2][2][4][2], const Unit& u, int wr, int wc, int fr, int fq) const {
        const int row0 = u.pm * BM + wr * 64 + fr; const int seg = u.pn >> 2, t4 = u.pn & 3;
        if (seg <= 1) {
            bf16_t* O = seg == 0 ? RQ : RK; const float sc = seg == 0 ? 1.0f : 0.08838834764831845f; const int o = 16 * wc + 4 * fq;
#pragma unroll
            for (int ai = 0; ai < 2; ++ai)
#pragma unroll
                for (int m = 0; m < 4; ++m) { const int row = row0 + ai * HALF + m * 16; const float r = rinv_of(ss, row) * sc;
                    const int slot = row < 16384 ? (row & 2047) : 2048 + (row & 63);
                    const f32x4 cs = *(const f32x4*)(rot + (size_t)slot * 128 + o), sn = *(const f32x4*)(rot + (size_t)slot * 128 + 64 + o);
#pragma unroll
                    for (int bj = 0; bj < 2; ++bj) { const f32x4 x1 = acc[ai][bj][m][0] * r, x2 = acc[ai][bj][m][1] * r; const f32x4 y1 = x1 * cs - x2 * sn, y2 = x1 * sn + x2 * cs;
                        bf16_t* p = O + (size_t)row * 1024 + (2 * t4 + bj) * 128 + o; u32x2 w1, w2; w1.x = cvt_pk_bf16(y1[0], y1[1]); w1.y = cvt_pk_bf16(y1[2], y1[3]); w2.x = cvt_pk_bf16(y2[0], y2[1]); w2.y = cvt_pk_bf16(y2[2], y2[3]);
                        *(u32x2*)p = w1; *(u32x2*)(p + 64) = w2; } }
        } else if (seg == 4 || seg == 5) {
            const float* gn = seg == 4 ? qg : kg; bf16_t* O = seg == 4 ? DQ : DK; const float sc = seg == 4 ? QSCALE : 1.0f;
            f32x4 gv[2][2];
#pragma unroll
            for (int bj = 0; bj < 2; ++bj)
#pragma unroll
                for (int n = 0; n < 2; ++n) gv[bj][n] = *(const f32x4*)(gn + 32 * bj + 8 * fq + 4 * n) * sc;
#pragma unroll
            for (int ai = 0; ai < 2; ++ai)
#pragma unroll
                for (int m = 0; m < 4; ++m) { const int row = row0 + ai * HALF + m * 16; const float r = rinv_of(ss, row); f32x4 v[2][2]; float sq = 0.f;
#pragma unroll
                    for (int bj = 0; bj < 2; ++bj)
#pragma unroll
                        for (int n = 0; n < 2; ++n) { v[bj][n] = acc[ai][bj][m][n] * r; sq += (v[bj][n][0] * v[bj][n][0] + v[bj][n][1] * v[bj][n][1]) + (v[bj][n][2] * v[bj][n][2] + v[bj][n][3] * v[bj][n][3]); }
                    sq += __shfl_xor(sq, 16); sq += __shfl_xor(sq, 32);
                    const float rr = rsqrtf(sq * (1.0f / 64.0f) + 1e-6f);
                    const int col = t4 * 256 + 64 * wc + 8 * fq;
                    float* kout = nullptr; if (seg == 5) kout = row < 16384 ? KP + (size_t)row * 1024 : KS + (size_t)(row - 16384) * 1024;
#pragma unroll
                    for (int bj = 0; bj < 2; ++bj) { const f32x4 a = v[bj][0] * rr * gv[bj][0], b = v[bj][1] * rr * gv[bj][1];
                        u32x4 w; w.x = cvt_pk_bf16(a[0], a[1]); w.y = cvt_pk_bf16(a[2], a[3]); w.z = cvt_pk_bf16(b[0], b[1]); w.w = cvt_pk_bf16(b[2], b[3]);
                        *(u32x4*)(O + (size_t)row * 1024 + col + 32 * bj) = w;
                        if (seg == 5) { *(f32x4*)(kout + col + 32 * bj) = a; *(f32x4*)(kout + col + 32 * bj + 4) = b; } } }
        } else {
            bf16_t* O; int ld, cb; int act = 0;
            if (seg == 2) { O = RV; ld = 1024; cb = t4 * 256; } else if (seg == 3) { O = RG; ld = 1024; cb = t4 * 256; act = 1; } else if (seg == 6) { O = DV; ld = 1024; cb = t4 * 256; }
            else if (seg <= 8) { O = GR; ld = 2048; cb = (u.pn - 28) * 256; act = 2; } else { O = GD; ld = 2048; cb = (u.pn - 36) * 256; act = 2; }
            const int col = cb + wc * 32 + 8 * fq;
#pragma unroll
            for (int ai = 0; ai < 2; ++ai)
#pragma unroll
                for (int m = 0; m < 4; ++m) { const int row = row0 + ai * HALF + m * 16; const float r = rinv_of(ss, row);
                    float* vout = nullptr; if (seg == 6) vout = row < 16384 ? VP + (size_t)row * 1024 : VS + (size_t)(row - 16384) * 1024;
#pragma unroll
                    for (int bj = 0; bj < 2; ++bj) { f32x4 a = acc[ai][bj][m][0] * r, b = acc[ai][bj][m][1] * r;
                        if (act == 1) { for (int e = 0; e < 4; ++e) { a[e] = silu_f(a[e]); b[e] = silu_f(b[e]); } }
                        if (act == 2) { for (int e = 0; e < 4; ++e) { a[e] = sigm_f(a[e]); b[e] = sigm_f(b[e]); } }
                        u32x4 w; w.x = cvt_pk_bf16(a[0], a[1]); w.y = cvt_pk_bf16(a[2], a[3]); w.z = cvt_pk_bf16(b[0], b[1]); w.w = cvt_pk_bf16(b[2], b[3]);
                        *(u32x4*)(O + (size_t)row * ld + col + bj * HALF) = w;
                        if (seg == 6) { *(f32x4*)(vout + col + bj * HALF) = a; *(f32x4*)(vout + col + bj * HALF + 4) = b; } } }
        }
    }
};

template <class Epi, class Sched, bool ALIGN_EPI = false, bool SP2 = false>
__device__ __forceinline__ void gemm_phase(PG8_LAS unsigned char* lds, const Gemm g, const Sched& S, const Epi& E) {
    int tid_o = threadIdx.x; asm volatile("" : "+v"(tid_o));
    const int tid = tid_o, wid = __builtin_amdgcn_readfirstlane(tid >> 6), lane = tid & 63, wr = wid >> 2, wc = wid & 3, fr = lane & 15, fq = lane >> 4;
    const int K = g.K, nt = K / BK;
    unsigned voffA[2], voffB[2];
#pragma unroll
    for (int i = 0; i < 2; ++i) { int R, C; stage_rc(tid * 16 + i * 8192, R, C); const int Rb = Epi::PERM ? ((R & ~31) + perm32(R & 31)) : R;
        voffA[i] = (unsigned)(R * K + C) * 2u; voffB[i] = (unsigned)(Rb * K + C) * 2u; }
    const size_t kstep = (size_t)(BK * 2);
    const size_t hstep = (size_t)HALF * K * 2;
    const size_t tstep = 2 * hstep;
    const unsigned ldsw = (unsigned)wid * 1024u;
    const int aoff = lds_byte(wr * 64 + fr, fq * 8), boff = lds_byte(wc * 32 + fr, fq * 8);
#define PG8_SA(b, h) (((b) * 2 + (h)) * HTB)
#define PG8_SB(b, h) ((4 + (b) * 2 + (h)) * HTB)
#define PG8_STAGE(bufoff, gbase, voff) do { _Pragma("unroll") for (int _i = 0; _i < 2; ++_i) \
        __builtin_amdgcn_global_load_lds((const unsigned*)((const char*)(gbase) + (voff)[_i]), (PG8_LAS unsigned*)(lds + (bufoff) + ldsw + _i * 8192), 16, 0, 0); } while (0)
#define PG8_LDA(dst, b, h) do { _Pragma("unroll") for (int m = 0; m < 4; ++m) _Pragma("unroll") for (int k = 0; k < 2; ++k) dst[m][k] = *(const PG8_LAS bf16x8*)(lds + PG8_SA(b, h) + aoff + m * 2048 + k * 1024); } while (0)
#define PG8_LDB(dst, b, h) do { _Pragma("unroll") for (int n = 0; n < 2; ++n) _Pragma("unroll") for (int k = 0; k < 2; ++k) dst[n][k] = *(const PG8_LAS bf16x8*)(lds + PG8_SB(b, h) + boff + n * 2048 + k * 1024); } while (0)
#define PG8_MMA(ai, bj, At, Bt) do { __builtin_amdgcn_s_setprio(1); _Pragma("unroll") for (int m = 0; m < 4; ++m) _Pragma("unroll") for (int n = 0; n < 2; ++n) _Pragma("unroll") for (int k = 0; k < 2; ++k) \
        acc[ai][bj][m][n] = __builtin_amdgcn_mfma_f32_16x16x32_bf16(Bt[n][k], At[m][k], acc[ai][bj][m][n], 0, 0, 0); __builtin_amdgcn_s_setprio(0); } while (0)
#define PG8_WAIT_V(n) asm volatile("s_waitcnt vmcnt(" #n ")" ::: "memory")
#define PG8_WAIT_L(n) asm volatile("s_waitcnt lgkmcnt(" #n ")" ::: "memory")
#define PG8_BAR __builtin_amdgcn_s_barrier()
#define PG8_SCHED __builtin_amdgcn_sched_barrier(0)
    Unit cur, nxt; int ui = 0;
    if (!S.next(0, cur)) return;
    f32x4 acc[2][2][4][2];
#pragma unroll
    for (int a = 0; a < 2; ++a)
#pragma unroll
        for (int b = 0; b < 2; ++b)
#pragma unroll
            for (int m = 0; m < 4; ++m)
#pragma unroll
                for (int n = 0; n < 2; ++n) acc[a][b][m][n] = (f32x4){0.f, 0.f, 0.f, 0.f};
    bf16x8 At[4][2], B0[2][2], B1[2][2];
    const char* cA = (const char*)g.A + (size_t)cur.pm * tstep; const char* cB = (const char*)g.Bt + (size_t)cur.pn * tstep;
    S.a_ready(cur);
    if constexpr (SP2) {
        PG8_STAGE(PG8_SB(0, 0), cB, voffB); PG8_STAGE(PG8_SB(0, 1), cB + hstep, voffB); PG8_STAGE(PG8_SA(0, 0), cA, voffA); PG8_STAGE(PG8_SA(0, 1), cA + hstep, voffA);
        if (wr == 1) PG8_BAR;
        PG8_WAIT_V(2); PG8_BAR;
        PG8_STAGE(PG8_SB(1, 0), cB + kstep, voffB); PG8_STAGE(PG8_SA(1, 0), cA + kstep, voffA); PG8_STAGE(PG8_SB(1, 1), cB + hstep + kstep, voffB);
        PG8_WAIT_V(6); PG8_BAR;
    } else {
        PG8_STAGE(PG8_SB(0, 0), cB, voffB); PG8_STAGE(PG8_SA(0, 0), cA, voffA); PG8_STAGE(PG8_SB(0, 1), cB + hstep, voffB); PG8_STAGE(PG8_SA(0, 1), cA + hstep, voffA);
        if (wr == 1) PG8_BAR;
        PG8_WAIT_V(4); PG8_BAR;
        PG8_STAGE(PG8_SB(1, 0), cB + kstep, voffB); PG8_STAGE(PG8_SA(1, 0), cA + kstep, voffA); PG8_STAGE(PG8_SB(1, 1), cB + hstep + kstep, voffB);
        PG8_WAIT_V(6); PG8_BAR;
    }
    for (;;) {
        const bool has_next = S.next(ui + 1, nxt);
        const char* nA = has_next ? (const char*)g.A + (size_t)nxt.pm * tstep : cA; const char* nB = has_next ? (const char*)g.Bt + (size_t)nxt.pn * tstep : cB;
        for (int t = 0; t < nt; t += 2) {
            const bool last = (t == nt - 2);
            const char* a1 = cA + (size_t)(t + 1) * kstep;
            const char* a2 = last ? nA : cA + (size_t)(t + 2) * kstep; const char* b2 = last ? nB : cB + (size_t)(t + 2) * kstep;
            const char* a3 = a2 + kstep; const char* b3 = b2 + kstep;
            if (last && has_next) S.a_ready(nxt);
            if constexpr (SP2) {
            PG8_LDB(B0, 0, 0); PG8_LDB(B1, 0, 1); PG8_SCHED; PG8_LDA(At, 0, 0); PG8_STAGE(PG8_SA(1, 1), a1 + hstep, voffA);
            PG8_WAIT_V(8); PG8_WAIT_L(0); PG8_BAR; PG8_MMA(0, 0, At, B0); PG8_MMA(0, 1, At, B1); PG8_BAR; PG8_SCHED;
            PG8_LDA(At, 0, 1); PG8_STAGE(PG8_SB(0, 0), b2, voffB); PG8_STAGE(PG8_SB(0, 1), b2 + hstep, voffB); PG8_STAGE(PG8_SA(0, 0), a2, voffA);
            PG8_WAIT_V(8); PG8_WAIT_L(0); PG8_BAR; PG8_MMA(1, 0, At, B0); PG8_MMA(1, 1, At, B1); PG8_BAR; PG8_SCHED;
            PG8_LDB(B0, 1, 0); PG8_LDB(B1, 1, 1); PG8_SCHED; PG8_LDA(At, 1, 0); PG8_STAGE(PG8_SA(0, 1), a2 + hstep, voffA);
            PG8_WAIT_V(8); PG8_WAIT_L(0); PG8_BAR; PG8_MMA(0, 0, At, B0); PG8_MMA(0, 1, At, B1); PG8_BAR; PG8_SCHED;
            PG8_LDA(At, 1, 1); PG8_STAGE(PG8_SB(1, 0), b3, voffB); PG8_STAGE(PG8_SB(1, 1), b3 + hstep, voffB); PG8_STAGE(PG8_SA(1, 0), a3, voffA);
            PG8_WAIT_V(8); PG8_WAIT_L(0); PG8_BAR; PG8_MMA(1, 0, At, B0); PG8_MMA(1, 1, At, B1); PG8_BAR; PG8_SCHED;
            } else {
            PG8_LDB(B0, 0, 0); PG8_SCHED; PG8_LDA(At, 0, 0); PG8_STAGE(PG8_SA(1, 1), a1 + hstep, voffA);
            PG8_WAIT_L(8); PG8_BAR; PG8_WAIT_L(0); PG8_MMA(0, 0, At, B0); PG8_BAR; PG8_SCHED;
            PG8_LDB(B1, 0, 1); PG8_STAGE(PG8_SB(0, 0), b2, voffB);
            PG8_BAR; PG8_WAIT_L(0); PG8_MMA(0, 1, At, B1); PG8_BAR;
            PG8_LDA(At, 0, 1); PG8_STAGE(PG8_SA(0, 0), a2, voffA);
            PG8_BAR; PG8_WAIT_L(0); PG8_MMA(1, 0, At, B0); PG8_BAR; PG8_SCHED;
            PG8_STAGE(PG8_SB(0, 1), b2 + hstep, voffB);
            PG8_WAIT_V(6); PG8_BAR; PG8_MMA(1, 1, At, B1); PG8_BAR;
            PG8_LDB(B0, 1, 0); PG8_SCHED; PG8_LDA(At, 1, 0); PG8_STAGE(PG8_SA(0, 1), a2 + hstep, voffA);
            PG8_WAIT_L(8); PG8_BAR; PG8_WAIT_L(0); PG8_MMA(0, 0, At, B0); PG8_BAR; PG8_SCHED;
            PG8_LDB(B1, 1, 1); PG8_STAGE(PG8_SB(1, 0), b3, voffB);
            PG8_BAR; PG8_WAIT_L(0); PG8_MMA(0, 1, At, B1); PG8_BAR;
            PG8_LDA(At, 1, 1); PG8_STAGE(PG8_SA(1, 0), a3, voffA);
            PG8_BAR; PG8_WAIT_L(0); PG8_MMA(1, 0, At, B0); PG8_BAR; PG8_SCHED;
            PG8_STAGE(PG8_SB(1, 1), b3 + hstep, voffB);
            PG8_WAIT_V(6); PG8_BAR; PG8_MMA(1, 1, At, B1); PG8_BAR;
            }
        }
        if constexpr (ALIGN_EPI) { if (wr == 0) PG8_BAR; }
        if constexpr (!Epi::AFTER_DRAIN) { E(acc, cur, wr, wc, fr, fq); S.done(cur); }
        if (!has_next) break;
#pragma unroll
        for (int a = 0; a < 2; ++a)
#pragma unroll
            for (int b = 0; b < 2; ++b)
#pragma unroll
                for (int m = 0; m < 4; ++m)
#pragma unroll
                    for (int n = 0; n < 2; ++n) acc[a][b][m][n] = (f32x4){0.f, 0.f, 0.f, 0.f};
        cur = nxt; cA = nA; cB = nB; ++ui;
        if constexpr (ALIGN_EPI) { if (wr == 1) PG8_BAR; }
    }
    PG8_WAIT_V(0);
    if constexpr (!ALIGN_EPI) { if (wr == 0) PG8_BAR; }
    PG8_BAR;
    if constexpr (Epi::AFTER_DRAIN) { E.fused(acc, cur, wr, wc, fr, fq, lds, wid, lane); S.done(cur); }
#undef PG8_SA
#undef PG8_SB
#undef PG8_STAGE
#undef PG8_LDA
#undef PG8_LDB
#undef PG8_MMA
#undef PG8_WAIT_V
#undef PG8_WAIT_L
#undef PG8_BAR
#undef PG8_SCHED
}
}

namespace mix {
#define LAS __attribute__((address_space(3)))
typedef unsigned short bf16_t;
typedef short bf16x8 __attribute__((ext_vector_type(8)));
typedef short s16x4 __attribute__((ext_vector_type(4)));
typedef float f32x4 __attribute__((ext_vector_type(4)));
typedef float f32x16 __attribute__((ext_vector_type(16)));
typedef unsigned u32x4 __attribute__((ext_vector_type(4)));
typedef unsigned u32x2 __attribute__((ext_vector_type(2)));
#define SBAR() __builtin_amdgcn_sched_barrier(0)
__device__ __forceinline__ int crow(int r, int hi) { return (r & 3) + 8 * (r >> 2) + 4 * hi; }
__device__ __forceinline__ unsigned cvtpk(float lo, float hi) { unsigned r; asm volatile("v_cvt_pk_bf16_f32 %0, %1, %2" : "=v"(r) : "v"(lo), "v"(hi)); return r; }
__device__ __forceinline__ bf16x8 pack8(f32x4 a, f32x4 b) { u32x4 w = {cvtpk(a[0], a[1]), cvtpk(a[2], a[3]), cvtpk(b[0], b[1]), cvtpk(b[2], b[3])}; return __builtin_bit_cast(bf16x8, w); }
__device__ __forceinline__ float bf_lo(unsigned w) { return __uint_as_float(w << 16); }
__device__ __forceinline__ float bf_hi(unsigned w) { return __uint_as_float(w & 0xffff0000u); }
__device__ __forceinline__ unsigned off_a(unsigned row, unsigned ch) { return 2048u * (row >> 3) + 512u * (ch >> 2) + 64u * (row & 7) + 16u * ((ch & 3) ^ ((row >> 2) & 3)); }
__device__ __forceinline__ unsigned rowb_of(int lane, int par) { const unsigned r = lane & 31, hi = lane >> 5; return 2048u * (r >> 3) + 64u * (r & 7) + 16u * ((2u * par + hi) ^ ((r >> 2) & 3)); }
__device__ __forceinline__ unsigned trb_of(int lane, int t) { const unsigned hi = lane >> 5, blk = (lane >> 4) & 1, q = (lane & 15) >> 2, p = lane & 3; return 2048u * hi + 64u * (4u * t + q) + 16u * ((2u * blk + (p >> 1)) ^ (2u * hi + t)) + 8u * (p & 1); }
template <int OFF> __device__ __forceinline__ s16x4 tr_read(unsigned a) { s16x4 r; asm volatile("ds_read_b64_tr_b16 %0, %1 offset:%2" : "=&v"(r) : "v"(a), "i"(OFF) : "memory"); return r; }
#define PK_LH(L, H) (bf16x8){L[0], L[1], L[2], L[3], H[0], H[1], H[2], H[3]}
#define PK4(P, BASE, OUT) do { unsigned a0_ = cvtpk(P[BASE + 0], P[BASE + 1]), a1_ = cvtpk(P[BASE + 2], P[BASE + 3]);   \
    unsigned b0_ = cvtpk(P[BASE + 4], P[BASE + 5]), b1_ = cvtpk(P[BASE + 6], P[BASE + 7]);                              \
    auto r0_ = __builtin_amdgcn_permlane32_swap(a0_, b0_, false, false); auto r1_ = __builtin_amdgcn_permlane32_swap(a1_, b1_, false, false); \
    u32x4 w_ = {r0_[0], r1_[0], r0_[1], r1_[1]}; OUT = __builtin_bit_cast(bf16x8, w_); } while (0)

__device__ __forceinline__ int t5_bucket(int rel) {
    const int base = rel > 0 ? 16 : 0, n = rel < 0 ? -rel : rel;
    int b;
    if (n < 8) b = n; else if (n < 12) b = 8; else if (n < 16) b = 9; else if (n < 23) b = 10; else if (n < 32) b = 11; else if (n < 46) b = 12; else if (n < 64) b = 13; else if (n < 91) b = 14; else b = 15;
    return base + b;
}

constexpr int AT_KV = 0;
constexpr int AT_X1 = 0;
constexpr int AT_Y = 65536;
constexpr int AT_BIAS = 133120;
constexpr int AT_WS = 134400;
constexpr int AT_END = 136448;

struct AttnP {
    const bf16_t* DQ; const bf16_t* DK; const bf16_t* DV;
    const float* ck; const float* cv;
    const float* nk; const float* nv;
    bf16_t* DO;
    float* part;
    const float* relb;
    const float* subln;
    float lam, omli;
};

__device__ __forceinline__ void attn_finalize(LAS unsigned char* lds, const f32x16 (&on)[4], bool act, int comp, int slot, size_t tok0, int h, const AttnP& P, int lane) {
    const int r32 = lane & 31, hi = lane >> 5;
    LAS float* X1 = (LAS float*)(lds + AT_X1) + slot * 4096;
    LAS float* Y = (LAS float*)(lds + AT_Y) + slot * (32 * 132);
    __syncthreads();
    if (act && comp == 1) {
#pragma unroll
        for (int d0 = 0; d0 < 4; ++d0)
#pragma unroll
            for (int r = 0; r < 16; ++r) X1[(d0 * 16 + r) * 64 + lane] = on[d0][r];
    }
    __syncthreads();
    if (act && comp == 0) {
#pragma unroll
        for (int d0 = 0; d0 < 4; ++d0)
#pragma unroll
            for (int r = 0; r < 16; ++r) Y[crow(r, hi) * 132 + d0 * 32 + r32] = on[d0][r] - P.lam * X1[(d0 * 16 + r) * 64 + lane];
        asm volatile("s_waitcnt lgkmcnt(0)" ::: "memory");
        f32x4 v[16]; float sq = 0.f;
#pragma unroll
        for (int j = 0; j < 16; ++j) { v[j] = *(const LAS f32x4*)(Y + r32 * 132 + 64 * hi + 4 * j); sq += (v[j][0] * v[j][0] + v[j][1] * v[j][1]) + (v[j][2] * v[j][2] + v[j][3] * v[j][3]); }
        { auto rr = __builtin_amdgcn_permlane32_swap(__float_as_uint(sq), __float_as_uint(sq), false, false); sq = __uint_as_float(rr[0]) + __uint_as_float(rr[1]); }
        const float rinv = rsqrtf(sq * (1.0f / 128.0f) + 1e-6f) * P.omli;
        bf16_t* orow = P.DO + (tok0 + r32) * 1024 + h * 128 + 64 * hi;
#pragma unroll
        for (int j = 0; j < 8; ++j) { const f32x4 g0 = *(const f32x4*)(P.subln + 64 * hi + 8 * j), g1 = *(const f32x4*)(P.subln + 64 * hi + 8 * j + 4);
            *(u32x4*)(orow + 8 * j) = __builtin_bit_cast(u32x4, pack8(v[2 * j] * rinv * g0, v[2 * j + 1] * rinv * g1)); }
    }
}

template <bool SAMPLE>
__device__ __forceinline__ void attn_unit(LAS unsigned char* lds, const AttnP& P, int b, int h, int x  ) {
    int tid_o = threadIdx.x; asm volatile("" : "+v"(tid_o)); const int tid = tid_o, lane = tid & 63, r32 = lane & 31, hi = lane >> 5; const int wid = __builtin_amdgcn_readfirstlane(tid >> 6);
    const int qt = SAMPLE ? ((wid >> 1) & 1) : (wid >> 1), comp = wid & 1;
    const bool wact = SAMPLE ? (wid < 4) : true;
    const int NT = SAMPLE ? (x == 3 ? 17 : 16) : (2 * x + 2);
    const int t0 = SAMPLE ? 16 * x : 0;
    const int nt_w = SAMPLE ? NT : (qt >= 2 ? NT : NT - 1);
    const int q0w = SAMPLE ? (PAST + 32 * qt) : (128 * x + 32 * qt);
    const size_t qtok = SAMPLE ? (size_t)(T_P + b * 64 + 32 * qt) : (size_t)(b * 2048 + 128 * x + 32 * qt);
    LAS float* btab = (LAS float*)(lds + AT_BIAS);
    LAS float* wsf = (LAS float*)(lds + AT_WS) + wid * 64;
    __syncthreads();
    if (tid < 320) btab[tid] = P.relb[t5_bucket(tid - 255) * 8 + h] * LOG2E;
    const float cfar = P.relb[15 * 8 + h] * LOG2E;
    bf16x8 qr[4];
#pragma unroll
    for (int d0 = 0; d0 < 4; ++d0) qr[d0] = *(const bf16x8*)(P.DQ + (qtok + r32) * 1024 + h * 128 + 64 * comp + 16 * d0 + 8 * hi);
    const int sr = tid >> 4, ch = tid & 15;
    const unsigned st0 = off_a(sr, ch), st1 = off_a(sr + 32, ch);
    const unsigned rb0 = rowb_of(lane, 0), rb1 = rowb_of(lane, 1), tb0 = trb_of(lane, 0), tb1 = trb_of(lane, 1);
    const unsigned ldsb = (unsigned)(uintptr_t)lds;
    bf16x8 sk0, sk1, sv0, sv1;
    f32x4 fk[4], fv[4];
#define AT_LOAD(t) do { if (SAMPLE) { const int tt_ = t0 + (t); const size_t ro_ = (tt_ < 64 ? ((size_t)b * PAST + 64 * tt_ + sr) : ((size_t)b * 64 + sr)) * 1024 + h * 128 + 8 * ch; \
        const float* a0_ = (tt_ < 64 ? P.ck : P.nk) + ro_; const float* c0_ = (tt_ < 64 ? P.cv : P.nv) + ro_; const float* a1_ = a0_ + 32 * 1024; const float* c1_ = c0_ + 32 * 1024; \
        fk[0] = *(const f32x4*)a0_; fk[1] = *(const f32x4*)(a0_ + 4); fk[2] = *(const f32x4*)a1_; fk[3] = *(const f32x4*)(a1_ + 4); fv[0] = *(const f32x4*)c0_; fv[1] = *(const f32x4*)(c0_ + 4); fv[2] = *(const f32x4*)c1_; fv[3] = *(const f32x4*)(c1_ + 4); } \
      else { const size_t ro_ = ((size_t)b * 2048 + 64 * (t) + sr) * 1024 + h * 128 + 8 * ch; \
        sk0 = *(const bf16x8*)(P.DK + ro_); sk1 = *(const bf16x8*)(P.DK + ro_ + 32 * 1024); sv0 = *(const bf16x8*)(P.DV + ro_); sv1 = *(const bf16x8*)(P.DV + ro_ + 32 * 1024); } } while (0)
#define AT_WRITE(buf) do { LAS unsigned char* kb_ = lds + AT_KV + (buf) * 32768; if (SAMPLE) { sk0 = pack8(fk[0], fk[1]); sk1 = pack8(fk[2], fk[3]); sv0 = pack8(fv[0], fv[1]); sv1 = pack8(fv[2], fv[3]); } \
        *(LAS bf16x8*)(kb_ + st0) = sk0; *(LAS bf16x8*)(kb_ + st1) = sk1; *(LAS bf16x8*)(kb_ + 16384 + st0) = sv0; *(LAS bf16x8*)(kb_ + 16384 + st1) = sv1; } while (0)
    float m_reg = -1e30f, l_reg = 0.f; f32x16 o[4];
#pragma unroll
    for (int d0 = 0; d0 < 4; ++d0) o[d0] = (f32x16){};
    AT_LOAD(0); AT_WRITE(0);
    if (NT > 1) AT_LOAD(1);
    __syncthreads();
    for (int j = 0; j < NT; ++j) {
        const int buf = j & 1;
        if (wact && j < nt_w) {
            LAS unsigned char* Kt = lds + AT_KV + buf * 32768; const unsigned Vt = ldsb + AT_KV + buf * 32768 + 16384;
            const int k0 = SAMPLE ? ((t0 + j) < 64 ? 64 * (t0 + j) : PAST) : 64 * j;
            f32x16 p0, p1;
            if (k0 + 63 - q0w <= -91) {
#pragma unroll
                for (int r = 0; r < 16; ++r) { p0[r] = cfar; p1[r] = cfar; }
            } else {
                const int ib = k0 - q0w - r32 + 4 * hi + 255;
#pragma unroll
                for (int r = 0; r < 16; ++r) { p0[r] = btab[ib + (r & 3) + 8 * (r >> 2)]; p1[r] = btab[ib + 32 + (r & 3) + 8 * (r >> 2)]; }
            }
#pragma unroll
            for (int d0 = 0; d0 < 4; ++d0) { const int s = 4 * comp + d0; const unsigned ro = ((s & 1) ? rb1 : rb0) + 512u * (s >> 1);
                const bf16x8 k0f = *(const LAS bf16x8*)(Kt + ro), k1f = *(const LAS bf16x8*)(Kt + 8192 + ro);
                p0 = __builtin_amdgcn_mfma_f32_32x32x16_bf16(k0f, qr[d0], p0, 0, 0, 0);
                p1 = __builtin_amdgcn_mfma_f32_32x32x16_bf16(k1f, qr[d0], p1, 0, 0, 0); }
            float pmax = p0[0];
#pragma unroll
            for (int r = 1; r < 16; ++r) pmax = fmaxf(pmax, p0[r]);
#pragma unroll
            for (int r = 0; r < 16; ++r) pmax = fmaxf(pmax, p1[r]);
            { auto rr = __builtin_amdgcn_permlane32_swap(__float_as_uint(pmax), __float_as_uint(pmax), false, false); pmax = fmaxf(__uint_as_float(rr[0]), __uint_as_float(rr[1])); }
            float alpha = 1.f;
            if (!__all(pmax - m_reg <= 8.0f)) { const float mn = fmaxf(m_reg, pmax); alpha = __builtin_amdgcn_exp2f(m_reg - mn); m_reg = mn;
                if (hi == 0) wsf[r32] = alpha; asm volatile("s_waitcnt lgkmcnt(0)" ::: "memory");
#pragma unroll
                for (int d0 = 0; d0 < 4; ++d0)
#pragma unroll
                    for (int r = 0; r < 16; ++r) o[d0][r] *= wsf[crow(r, hi)];
            }
            float ps = 0.f;
#pragma unroll
            for (int r = 0; r < 16; ++r) { p0[r] = __builtin_amdgcn_exp2f(p0[r] - m_reg); p1[r] = __builtin_amdgcn_exp2f(p1[r] - m_reg); ps += p0[r] + p1[r]; }
            { auto rr = __builtin_amdgcn_permlane32_swap(__float_as_uint(ps), __float_as_uint(ps), false, false); ps = __uint_as_float(rr[0]) + __uint_as_float(rr[1]); }
            l_reg = l_reg * alpha + ps;
            bf16x8 pa0, pa1, pa2, pa3;
            PK4(p0, 0, pa0); PK4(p0, 8, pa1); PK4(p1, 0, pa2); PK4(p1, 8, pa3);
#define AT_PV(D0) do { const s16x4 l0_ = tr_read<(D0) * 512>(Vt + tb0), h0_ = tr_read<(D0) * 512>(Vt + tb1), l1_ = tr_read<(D0) * 512 + 4096>(Vt + tb0), h1_ = tr_read<(D0) * 512 + 4096>(Vt + tb1); \
                const s16x4 l2_ = tr_read<(D0) * 512 + 8192>(Vt + tb0), h2_ = tr_read<(D0) * 512 + 8192>(Vt + tb1), l3_ = tr_read<(D0) * 512 + 12288>(Vt + tb0), h3_ = tr_read<(D0) * 512 + 12288>(Vt + tb1); \
                asm volatile("s_waitcnt lgkmcnt(0)" ::: "memory"); SBAR(); \
                o[D0] = __builtin_amdgcn_mfma_f32_32x32x16_bf16(pa0, PK_LH(l0_, h0_), o[D0], 0, 0, 0); o[D0] = __builtin_amdgcn_mfma_f32_32x32x16_bf16(pa1, PK_LH(l1_, h1_), o[D0], 0, 0, 0); \
                o[D0] = __builtin_amdgcn_mfma_f32_32x32x16_bf16(pa2, PK_LH(l2_, h2_), o[D0], 0, 0, 0); o[D0] = __builtin_amdgcn_mfma_f32_32x32x16_bf16(pa3, PK_LH(l3_, h3_), o[D0], 0, 0, 0); } while (0)
            AT_PV(0); AT_PV(1); AT_PV(2); AT_PV(3);
        }
        if (j + 1 < NT) { AT_WRITE(buf ^ 1); }
        if (j + 2 < NT) { AT_LOAD(j + 2); }
        __syncthreads();
    }
    if (SAMPLE) {
        if (wact) {
            float* rec = P.part + ((size_t)((b * 8 + h) * 4 + x) * 4 + wid) * 4224;
#pragma unroll
            for (int d0 = 0; d0 < 4; ++d0)
#pragma unroll
                for (int r = 0; r < 16; ++r) rec[(d0 * 16 + r) * 64 + lane] = o[d0][r];
            if (hi == 0) { rec[4096 + r32] = m_reg; rec[4128 + r32] = l_reg; }
        }
    } else {
        if (hi == 0) wsf[r32] = l_reg; asm volatile("s_waitcnt lgkmcnt(0)" ::: "memory");
#pragma unroll
        for (int r = 0; r < 16; ++r) { const float il = __builtin_amdgcn_rcpf(wsf[crow(r, hi)]);
#pragma unroll
            for (int d0 = 0; d0 < 4; ++d0) o[d0][r] *= il; }
        attn_finalize(lds, o, true, comp, qt, qtok, h, P, lane);
    }
#undef AT_LOAD
#undef AT_WRITE
#undef AT_PV
}

__device__ __forceinline__ void attn_merge_unit(LAS unsigned char* lds, const AttnP& P, int b, int h) {
    int tid_o = threadIdx.x; asm volatile("" : "+v"(tid_o)); const int tid = tid_o, lane = tid & 63, r32 = lane & 31, hi = lane >> 5; const int wid = __builtin_amdgcn_readfirstlane(tid >> 6);
    const bool wact = wid < 4; const int qt = (wid >> 1) & 1, comp = wid & 1;
    LAS float* wsf = (LAS float*)(lds + AT_WS) + wid * 64;
    LAS float* sc = (LAS float*)(lds + AT_WS) + (wid & 3) * 128;
    f32x16 on[4];
#pragma unroll
    for (int d0 = 0; d0 < 4; ++d0) on[d0] = (f32x16){};
    __syncthreads();
    if (wact) {
        const float* rec = P.part + ((size_t)((b * 8 + h) * 4) * 4 + wid) * 4224;
        float ms[4], ls[4]; float M = -1e30f;
#pragma unroll
        for (int s = 0; s < 4; ++s) { ms[s] = rec[(size_t)s * 16896 + 4096 + r32]; ls[s] = rec[(size_t)s * 16896 + 4128 + r32]; M = fmaxf(M, ms[s]); }
        float L = 0.f;
#pragma unroll
        for (int s = 0; s < 4; ++s) { ms[s] = __builtin_amdgcn_exp2f(ms[s] - M); L += ls[s] * ms[s]; }
        const float iL = 1.0f / L;
        if (hi == 0) {
#pragma unroll
            for (int s = 0; s < 4; ++s) sc[s * 32 + r32] = ms[s] * iL; }
        asm volatile("s_waitcnt lgkmcnt(0)" ::: "memory");
#pragma unroll
        for (int s = 0; s < 4; ++s) {
#pragma unroll
            for (int r = 0; r < 16; ++r) { const float w = sc[s * 32 + crow(r, hi)];
#pragma unroll
                for (int d0 = 0; d0 < 4; ++d0) on[d0][r] += w * rec[(size_t)s * 16896 + (d0 * 16 + r) * 64 + lane]; } }
    }
    (void)wsf;
    attn_finalize(lds, on, wact, comp, qt, (size_t)(T_P + b * 64 + 32 * qt), h, P, lane);
}

constexpr int RT_Q = 0, RT_K = 16384, RT_V = 32768, RT_KW = 49152, RT_OUT = 65536;
constexpr int RT_END = RT_OUT + 64 * 132 * 4;
struct RetP {
    const bf16_t* RQ; const bf16_t* RK; const bf16_t* RV; const bf16_t* RG;
    bf16_t* RO;
    const float* s0;
    float* sP; float* sS;
};
__device__ __forceinline__ void ret_unit(LAS unsigned char* lds, const RetP& P, bool sample, int b, int h) {
    int tid_o = threadIdx.x; asm volatile("" : "+v"(tid_o)); const int tid = tid_o, lane = tid & 63, r32 = lane & 31, hi = lane >> 5; const int wid = __builtin_amdgcn_readfirstlane(tid >> 6);
    const int et = wid & 3, ih = wid >> 2;
    const int nch = sample ? 1 : 32;
    const size_t tok0 = sample ? (size_t)(T_P + b * 64) : (size_t)b * 2048;
    const float lg2 = log1pf(-__builtin_amdgcn_exp2f((float)(-5 - h))) * LOG2E;
    const float dec = __builtin_amdgcn_exp2f(lg2 * 64.0f);
    const int sr = tid >> 4, ch = tid & 15;
    const unsigned st0 = off_a(sr, ch), st1 = off_a(sr + 32, ch);
    const float we0 = __builtin_amdgcn_exp2f(lg2 * (float)(63 - sr)), we1 = __builtin_amdgcn_exp2f(lg2 * (float)(31 - sr));
    const unsigned rb0 = rowb_of(lane, 0), rb1 = rowb_of(lane, 1), tb0 = trb_of(lane, 0), tb1 = trb_of(lane, 1);
    const unsigned ldsb = (unsigned)(uintptr_t)lds;
    LAS float* OUT = (LAS float*)(lds + RT_OUT);
    f32x16 S[4];
    if (sample) { const float* s = P.s0 + ((size_t)(b * 8 + h) * 128) * 128 + 32 * et + r32;
#pragma unroll
        for (int dt = 0; dt < 4; ++dt)
#pragma unroll
            for (int r = 0; r < 16; ++r) S[dt][r] = s[(size_t)(32 * dt + crow(r, hi)) * 128]; }
    else {
#pragma unroll
        for (int dt = 0; dt < 4; ++dt) S[dt] = (f32x16){}; }
    const float dmb = (float)(32 * ih + r32 - 4 * hi);
    unsigned qpb[4];
#pragma unroll
    for (int q = 0; q < 4; ++q) { const unsigned row = 32 * ih + r32; qpb[q] = 2048u * (row >> 3) + 64u * (row & 7) + 16u * ((unsigned)q ^ ((row >> 2) & 3)) + 8u * hi; }
    bf16x8 gq0, gq1, gk0, gk1, gv0, gv1;
#define RT_LOAD(c) do { const size_t t_ = tok0 + 64 * (c); const size_t o0_ = (t_ + sr) * 1024 + h * 128 + 8 * ch, o1_ = (t_ + sr + 32) * 1024 + h * 128 + 8 * ch; \
        gq0 = *(const bf16x8*)(P.RQ + o0_); gq1 = *(const bf16x8*)(P.RQ + o1_); gk0 = *(const bf16x8*)(P.RK + o0_); gk1 = *(const bf16x8*)(P.RK + o1_); gv0 = *(const bf16x8*)(P.RV + o0_); gv1 = *(const bf16x8*)(P.RV + o1_); } while (0)
    RT_LOAD(0);
    __syncthreads();
    for (int c = 0; c < nch; ++c) {
        float lgc = lg2; asm volatile("" : "+v"(lgc));
        { *(LAS bf16x8*)(lds + RT_Q + st0) = gq0; *(LAS bf16x8*)(lds + RT_Q + st1) = gq1; *(LAS bf16x8*)(lds + RT_K + st0) = gk0; *(LAS bf16x8*)(lds + RT_K + st1) = gk1;
          *(LAS bf16x8*)(lds + RT_V + st0) = gv0; *(LAS bf16x8*)(lds + RT_V + st1) = gv1;
          const u32x4 a = __builtin_bit_cast(u32x4, gk0), bq = __builtin_bit_cast(u32x4, gk1); u32x4 wa, wb;
#pragma unroll
          for (int q = 0; q < 4; ++q) { wa[q] = cvtpk(bf_lo(a[q]) * we0, bf_hi(a[q]) * we0); wb[q] = cvtpk(bf_lo(bq[q]) * we1, bf_hi(bq[q]) * we1); }
          *(LAS u32x4*)(lds + RT_KW + st0) = wa; *(LAS u32x4*)(lds + RT_KW + st1) = wb; }
        __syncthreads();
        if (c + 1 < nch) RT_LOAD(c + 1);
        f32x16 p0 = (f32x16){}, p1 = (f32x16){};
#pragma unroll
        for (int s = 0; s < 8; ++s) { const unsigned ro = ((s & 1) ? rb1 : rb0) + 512u * (s >> 1);
            const bf16x8 k0f = *(const LAS bf16x8*)(lds + RT_K + ro), k1f = *(const LAS bf16x8*)(lds + RT_K + 8192 + ro), qf = *(const LAS bf16x8*)(lds + RT_Q + 8192 * ih + ro);
            p0 = __builtin_amdgcn_mfma_f32_32x32x16_bf16(k0f, qf, p0, 0, 0, 0); p1 = __builtin_amdgcn_mfma_f32_32x32x16_bf16(k1f, qf, p1, 0, 0, 0); }
#pragma unroll
        for (int r = 0; r < 16; ++r) { const float dj = dmb - (float)((r & 3) + 8 * (r >> 2));
            p0[r] *= __builtin_amdgcn_exp2f(lgc * __builtin_fabsf(dj)); p1[r] *= __builtin_amdgcn_exp2f(lgc * __builtin_fabsf(dj - 32.0f)); }
        bf16x8 pa0, pa1, pa2, pa3;
        PK4(p0, 0, pa0); PK4(p0, 8, pa1); PK4(p1, 0, pa2); PK4(p1, 8, pa3);
        bf16x8 vf[4];
        { const unsigned Vt = ldsb + RT_V + 512u * et;
          const s16x4 l0_ = tr_read<0>(Vt + tb0), h0_ = tr_read<0>(Vt + tb1), l1_ = tr_read<4096>(Vt + tb0), h1_ = tr_read<4096>(Vt + tb1);
          const s16x4 l2_ = tr_read<8192>(Vt + tb0), h2_ = tr_read<8192>(Vt + tb1), l3_ = tr_read<12288>(Vt + tb0), h3_ = tr_read<12288>(Vt + tb1);
          asm volatile("s_waitcnt lgkmcnt(0)" ::: "memory"); SBAR();
          vf[0] = PK_LH(l0_, h0_); vf[1] = PK_LH(l1_, h1_); vf[2] = PK_LH(l2_, h2_); vf[3] = PK_LH(l3_, h3_); }
        f32x16 oi = (f32x16){}, oe = (f32x16){};
        oi = __builtin_amdgcn_mfma_f32_32x32x16_bf16(pa0, vf[0], oi, 0, 0, 0); oi = __builtin_amdgcn_mfma_f32_32x32x16_bf16(pa1, vf[1], oi, 0, 0, 0);
        oi = __builtin_amdgcn_mfma_f32_32x32x16_bf16(pa2, vf[2], oi, 0, 0, 0); oi = __builtin_amdgcn_mfma_f32_32x32x16_bf16(pa3, vf[3], oi, 0, 0, 0);
#pragma unroll
        for (int dt = 0; dt < 4; ++dt)
#pragma unroll
            for (int s = 0; s < 2; ++s) {
                const s16x4 qa = *(const LAS s16x4*)(lds + RT_Q + qpb[2 * s] + 512 * dt), qb = *(const LAS s16x4*)(lds + RT_Q + qpb[2 * s + 1] + 512 * dt);
                u32x4 sw; sw[0] = cvtpk(S[dt][8 * s + 0], S[dt][8 * s + 1]); sw[1] = cvtpk(S[dt][8 * s + 2], S[dt][8 * s + 3]); sw[2] = cvtpk(S[dt][8 * s + 4], S[dt][8 * s + 5]); sw[3] = cvtpk(S[dt][8 * s + 6], S[dt][8 * s + 7]);
                oe = __builtin_amdgcn_mfma_f32_32x32x16_bf16(PK_LH(qa, qb), __builtin_bit_cast(bf16x8, sw), oe, 0, 0, 0); }
#pragma unroll
        for (int r = 0; r < 16; ++r) OUT[(32 * ih + crow(r, hi)) * 132 + 32 * et + r32] = oi[r] + __builtin_amdgcn_exp2f(lgc * (float)(32 * ih + crow(r, hi) + 1)) * oe[r];
#pragma unroll
        for (int dt = 0; dt < 4; ++dt) {
            const unsigned Kw = ldsb + RT_KW + 512u * dt;
            const s16x4 l0_ = tr_read<0>(Kw + tb0), h0_ = tr_read<0>(Kw + tb1), l1_ = tr_read<4096>(Kw + tb0), h1_ = tr_read<4096>(Kw + tb1);
            const s16x4 l2_ = tr_read<8192>(Kw + tb0), h2_ = tr_read<8192>(Kw + tb1), l3_ = tr_read<12288>(Kw + tb0), h3_ = tr_read<12288>(Kw + tb1);
            asm volatile("s_waitcnt lgkmcnt(0)" ::: "memory"); SBAR();
#pragma unroll
            for (int r = 0; r < 16; ++r) S[dt][r] *= dec;
            S[dt] = __builtin_amdgcn_mfma_f32_32x32x16_bf16(PK_LH(l0_, h0_), vf[0], S[dt], 0, 0, 0); S[dt] = __builtin_amdgcn_mfma_f32_32x32x16_bf16(PK_LH(l1_, h1_), vf[1], S[dt], 0, 0, 0);
            S[dt] = __builtin_amdgcn_mfma_f32_32x32x16_bf16(PK_LH(l2_, h2_), vf[2], S[dt], 0, 0, 0); S[dt] = __builtin_amdgcn_mfma_f32_32x32x16_bf16(PK_LH(l3_, h3_), vf[3], S[dt], 0, 0, 0); }
        __syncthreads();
        { const int row = tid >> 3, sg = tid & 7; f32x4 v[4]; float sq = 0.f;
#pragma unroll
          for (int q = 0; q < 4; ++q) { v[q] = *(const LAS f32x4*)(OUT + row * 132 + 16 * sg + 4 * q); sq += (v[q][0] * v[q][0] + v[q][1] * v[q][1]) + (v[q][2] * v[q][2] + v[q][3] * v[q][3]); }
          sq += __shfl_xor(sq, 1); sq += __shfl_xor(sq, 2); sq += __shfl_xor(sq, 4);
          const float rinv = rsqrtf(sq * (1.0f / 128.0f) + 1e-6f);
          const size_t go = (tok0 + 64 * c + row) * 1024 + h * 128 + 16 * sg;
          const u32x4 g0 = *(const u32x4*)(P.RG + go), g1 = *(const u32x4*)(P.RG + go + 8);
          f32x4 ga, gb, gc, gd;
          ga = (f32x4){bf_lo(g0[0]), bf_hi(g0[0]), bf_lo(g0[1]), bf_hi(g0[1])}; gb = (f32x4){bf_lo(g0[2]), bf_hi(g0[2]), bf_lo(g0[3]), bf_hi(g0[3])};
          gc = (f32x4){bf_lo(g1[0]), bf_hi(g1[0]), bf_lo(g1[1]), bf_hi(g1[1])}; gd = (f32x4){bf_lo(g1[2]), bf_hi(g1[2]), bf_lo(g1[3]), bf_hi(g1[3])};
          *(u32x4*)(P.RO + go) = __builtin_bit_cast(u32x4, pack8(v[0] * rinv * ga, v[1] * rinv * gb));
          *(u32x4*)(P.RO + go + 8) = __builtin_bit_cast(u32x4, pack8(v[2] * rinv * gc, v[3] * rinv * gd)); }
    }
    if (ih == 0) { float* so = (sample ? P.sS : P.sP) + ((size_t)(b * 8 + h) * 128) * 128 + 32 * et + r32;
#pragma unroll
        for (int dt = 0; dt < 4; ++dt)
#pragma unroll
            for (int r = 0; r < 16; ++r) so[(size_t)(32 * dt + crow(r, hi)) * 128] = S[dt][r]; }
#undef RT_LOAD
}
#undef LAS
}

#ifndef MK_PER_PHASE
#define MK_PER_PHASE 0
#endif
constexpr int NWAVES = 8;
constexpr int NPHASE = 1 + 9 * DEPTH;
constexpr size_t MiB = 1u << 20;
constexpr size_t WS_CTL = 0, CTL_ZERO_BYTES = 1 * MiB;
constexpr size_t WS_ROT = 1 * MiB;
constexpr size_t WS_LAM = 3 * MiB;
constexpr size_t WS_W = 4 * MiB;
constexpr size_t O_WGU1 = 0, O_WD1 = 23068672, O_WIN = 34603008, O_WR = 57671680, O_WDU = 59768832, O_WO = 61865984, O_WGU2 = 66060288, O_WD2 = 89128960, LAYER_W = 100663296;
constexpr size_t WS_XB = 388 * MiB, WS_HID = 454 * MiB;
constexpr size_t WS_RQ = 636 * MiB, WS_RK = 669 * MiB, WS_RV = 702 * MiB, WS_RG = 735 * MiB, WS_DQ = 768 * MiB, WS_DK = 801 * MiB, WS_DV = 834 * MiB;
constexpr size_t WS_GR = 867 * MiB, WS_GD = 933 * MiB, WS_RO = 999 * MiB, WS_DO = 1032 * MiB, WS_MRG = 1065 * MiB, WS_PART = 1131 * MiB, WS_END = 1148 * MiB;
static_assert(WS_W + 2 * LAYER_W * 2 <= WS_XB && WS_XB + (size_t)TT * 2048 * 2 <= WS_HID && WS_HID + (size_t)TT * 5632 * 2 <= WS_RQ && WS_RQ + (size_t)TT * 1024 * 2 <= WS_RK, "ws map");
static_assert(WS_PART + (size_t)64 * 4 * 4 * 4224 * 4 <= WS_END, "ws map");
constexpr int CW_TMO = 0, CW_BAR = 4096, CW_SS = 16384;
static_assert((CW_SS + 7 * TT) * 4 <= (int)CTL_ZERO_BYTES, "ctl");
constexpr size_t OUT_Y = 0, OUT_KP = 34603008, OUT_VP = 68157440, OUT_RP = 101711872, OUT_KS = 103809024, OUT_VS = 104857600, OUT_RS = 105906176, OUT_END = 108003328;
constexpr int LDS_BYTES = 163840, MISC_OFF = LDS_BYTES - 256;
static_assert(mix::AT_END <= MISC_OFF && mix::RT_END <= MISC_OFF && pg8::STAGE_BYTES <= MISC_OFF, "lds map");

#define GAS __attribute__((address_space(1)))
#define LAS __attribute__((address_space(3)))
typedef unsigned short bf16;
typedef unsigned v4u __attribute__((ext_vector_type(4)));
typedef float f32x4 __attribute__((ext_vector_type(4)));
__device__ __forceinline__ unsigned f2bf(float f) { unsigned u = __builtin_bit_cast(unsigned, f); return (u + 0x7fffu + ((u >> 16) & 1u)) >> 16; }
__device__ __forceinline__ unsigned pk2(float lo, float hi) { return f2bf(lo) | (f2bf(hi) << 16); }
__device__ __forceinline__ float wave_sum(float v) {
#pragma unroll
    for (int o = 1; o < 64; o <<= 1) v += __shfl_xor(v, o);
    return v;
}

#define XB_TMO      128
#define XB_XCNT(j)  (256  + 64 * (j))
#define XB_XSUB(j)  (1280 + 64 * (j))
#define XB_XGEN(j)  (2304 + 64 * (j))
#define XB_TOP      3328
#define XB_TOPGEN   3392
#define XCD_BAR_WORDS 3456
#define XB_SPIN_CAP (1u << 18)

__device__ __forceinline__ unsigned xb_ld(unsigned* p)              { return __hip_atomic_load(p, __ATOMIC_RELAXED, __HIP_MEMORY_SCOPE_AGENT); }
__device__ __forceinline__ unsigned xb_add(unsigned* p, unsigned v) { return __hip_atomic_fetch_add(p, v, __ATOMIC_RELAXED, __HIP_MEMORY_SCOPE_AGENT); }
__device__ __forceinline__ unsigned xb_xcc_id() { return (unsigned)__builtin_amdgcn_s_getreg((3 << 11) | 20) & 0xFu; }
#define XB_SPIN(cond, bar) do { unsigned _sp = 0; while (cond) { __builtin_amdgcn_s_sleep(1); \
    if ((++_sp & 255u) == 0u) { if (xb_ld(&(bar)[XB_TMO])) break; if (_sp > XB_SPIN_CAP) { atomicAdd(&(bar)[XB_TMO], 1u); break; } } } } while (0)

struct XcdBarrier {
    unsigned* bar; unsigned x;
    volatile LAS unsigned* st;
};

__device__ __forceinline__ XcdBarrier xcd_barrier_post(unsigned* bar, volatile LAS unsigned* st) {
    XcdBarrier b; b.bar = bar; b.x = xb_xcc_id(); b.st = st;
    if (threadIdx.x == 0) (void)xb_add(&bar[XB_XCNT(b.x)], 1u);
    return b;
}
__device__ __forceinline__ void xcd_barrier_complete(unsigned* bar, unsigned x, unsigned& nloc, unsigned& nx) {
    const unsigned G = gridDim.x * gridDim.y * gridDim.z;
    unsigned sum, cnt, mine, sp = 0u;
    for (;;) {
        sum = 0u; cnt = 0u; mine = 0u;
#pragma unroll
        for (unsigned j = 0; j < 16; ++j) { const unsigned c = xb_ld(&bar[XB_XCNT(j)]); sum += c; cnt += (c > 0u) ? 1u : 0u; mine = (j == x) ? c : mine; }
        if (sum == G) break;
        __builtin_amdgcn_s_sleep(1);
        if ((++sp & 255u) == 0u) { if (xb_ld(&bar[XB_TMO])) break; if (sp > XB_SPIN_CAP) { atomicAdd(&bar[XB_TMO], 1u); break; } }
    }
    nloc = mine > 0u ? mine : 1u; nx = cnt > 0u ? cnt : 1u;
}

__device__ __forceinline__ void xcd_barrier(const XcdBarrier& b) {
    asm volatile("s_waitcnt vmcnt(0)" ::: "memory");
    __syncthreads();
    if (threadIdx.x == 0) {
        unsigned* bar = b.bar;
        __builtin_amdgcn_s_waitcnt(0);
        unsigned nloc = b.st[0], nx = b.st[1];
        if (nloc == 0u) { xcd_barrier_complete(bar, b.x, nloc, nx); b.st[0] = nloc; b.st[1] = nx; }
        const unsigned old = xb_add(&bar[XB_XSUB(b.x)], 1u);
        const unsigned gen = old / nloc;
        if (old + 1u == (gen + 1u) * nloc) {
            __builtin_amdgcn_fence(__ATOMIC_RELEASE, "agent");
            asm volatile("s_waitcnt vmcnt(0)" ::: "memory");
            const unsigned og = xb_add(&bar[XB_TOP], 1u);
            const unsigned tg = og / nx;
            if (og + 1u == (tg + 1u) * nx) xb_add(&bar[XB_TOPGEN], 1u);
            else XB_SPIN(xb_ld(&bar[XB_TOPGEN]) == tg, bar);
            __builtin_amdgcn_fence(__ATOMIC_ACQUIRE, "agent");
            xb_add(&bar[XB_XGEN(b.x)], 1u);
            asm volatile("s_waitcnt vmcnt(0)" ::: "memory");
        } else {
            XB_SPIN(xb_ld(&bar[XB_XGEN(b.x)]) == gen, bar);
            __builtin_amdgcn_fence(__ATOMIC_ACQUIRE, "agent");
            asm volatile("s_waitcnt vmcnt(0)" ::: "memory");
        }
    }
    __syncthreads();
}


struct Args { const float* in[26]; float* out; unsigned char* ws; int ph_lo, ph_hi; };

__device__ __forceinline__ void p0_item(const float* src, int ld, int k0, int col, const float* gain, bf16* dst, int K, int p0, LAS float* scr, int lane) {
#pragma unroll 8
    for (int i = 0; i < 32; ++i) { const int kk = 2 * i + (lane >> 5); float v = src[(size_t)(k0 + kk) * ld + col]; if (gain) v *= gain[k0 + kk]; scr[kk * 33 + (lane & 31)] = v; }
    asm volatile("s_waitcnt lgkmcnt(0)" ::: "memory");
    const int c = lane & 7;
#pragma unroll
    for (int j = 0; j < 4; ++j) { const int n = (lane >> 3) + 8 * j; const LAS float* s = scr + (8 * c) * 33 + n;
        v4u o; o.x = pk2(s[0 * 33], s[1 * 33]); o.y = pk2(s[2 * 33], s[3 * 33]); o.z = pk2(s[4 * 33], s[5 * 33]); o.w = pk2(s[6 * 33], s[7 * 33]);
        *(v4u*)(dst + (size_t)(p0 + n) * K + k0 + 8 * c) = o; }
    asm volatile("s_waitcnt lgkmcnt(0)" ::: "memory");
}

__device__ __forceinline__ void p0_prologue(const Args& a, LAS unsigned char* lds, int gw, int NGW, int lane, int wave) {
    LAS float* scr = (LAS float*)(lds + wave * 16384);
    bf16* W = (bf16*)(a.ws + WS_W);
    const int li = lane & 31;
    for (int it = gw; it < 2 * 49152; it += NGW) {
        const int l = it / 49152; int r = it % 49152; bf16* Wl = W + (size_t)l * LAYER_W;
        if (r < 11264 || (r >= 32256 && r < 43520)) {
            const bool second = r >= 32256; if (second) r -= 32256;
            const int kb = r / 352, pb = r % 352, p0 = 32 * pb; const bool up = (p0 & 255) >= 128;
            const float* src = a.in[second ? (up ? 23 : 22) : (up ? 7 : 6)] + (size_t)l * 2048 * 5632;
            p0_item(src, 5632, 64 * kb, 128 * (p0 >> 8) + (p0 & 127) + li, a.in[second ? 21 : 5] + l * 2048, Wl + (second ? O_WGU2 : O_WGU1), 2048, p0, scr, lane);
        } else if ((r >= 11264 && r < 16896) || r >= 43520) {
            const bool second = r >= 43520; r -= second ? 43520 : 11264;
            const int kb = r / 64, pb = r % 64;
            p0_item(a.in[second ? 24 : 8] + (size_t)l * 5632 * 2048, 2048, 64 * kb, 32 * pb + li, nullptr, Wl + (second ? O_WD2 : O_WD1), 5632, 32 * pb, scr, lane);
        } else if (r < 28160) {
            r -= 16896; const int kb = r / 352, pb = r % 352, p0 = 32 * pb, seg = p0 >> 10; int col;
            if (seg <= 1) { const int wc = (p0 & 127) >> 5; col = (p0 & ~127) + 16 * wc + 4 * (li >> 3) + (li & 3) + 64 * ((li >> 2) & 1); }
            else if (seg == 4 || seg == 5) { const int pt = p0 & 255; col = (p0 & ~255) + 64 * ((pt >> 5) & 3) + 32 * (pt >> 7) + li; }
            else col = p0 + li;
            p0_item(a.in[10] + (size_t)l * 2048 * 11264, 11264, 64 * kb, col, a.in[9] + l * 2048, Wl + O_WIN, 2048, p0, scr, lane);
        } else if (r < 30208) {
            const bool dif = r >= 29184; r -= dif ? 29184 : 28160; const int kb = r / 64, pb = r % 64;
            p0_item(a.in[dif ? 19 : 18] + (size_t)l * 1024 * 2048, 2048, 64 * kb, 32 * pb + li, nullptr, Wl + (dif ? O_WDU : O_WR), 1024, 32 * pb, scr, lane);
        } else {
            r -= 30208; const int kb = r / 64, pb = r % 64;
            p0_item(a.in[20] + (size_t)l * 2048 * 2048, 2048, 64 * kb, 32 * pb + li, nullptr, Wl + O_WO, 2048, 32 * pb, scr, lane);
        }
    }
    { bf16* XB = (bf16*)(a.ws + WS_XB); float* ss0 = (float*)(a.ws + WS_CTL) + CW_SS;
      for (int t = gw; t < TT; t += NGW) { const float* xr = t < T_P ? a.in[0] + (size_t)t * 2048 : a.in[1] + (size_t)(t - T_P) * 2048;
          f32x4 v[8]; float s = 0.f;
#pragma unroll
          for (int j = 0; j < 8; ++j) { v[j] = *((const f32x4*)xr + lane + 64 * j); s += (v[j][0] * v[j][0] + v[j][1] * v[j][1]) + (v[j][2] * v[j][2] + v[j][3] * v[j][3]); }
          s = wave_sum(s);
          unsigned long long* o8 = (unsigned long long*)(XB + (size_t)t * 2048) + lane;
#pragma unroll
          for (int j = 0; j < 8; ++j) o8[64 * j] = (unsigned long long)pk2(v[j][0], v[j][1]) | ((unsigned long long)pk2(v[j][2], v[j][3]) << 32);
          if (lane == 0) ss0[t] = s; } }
    { float* rot = (float*)(a.ws + WS_ROT);
      for (int idx = gw * 64 + lane; idx < 2112 * 64; idx += NGW * 64) { const int slot = idx >> 6, i = idx & 63; const double pos = (double)(slot < 2048 ? slot : slot + 2048);
          double inv = 1.0; for (int q = 0; q < i; ++q) inv *= 0.8659643233600653;
          const double ang = pos * inv; const double k = __builtin_rint(ang * 0.6366197723675814);
          double r = __builtin_fma(-k, 1.5707963267948966, ang); r = __builtin_fma(-k, 6.123233995736766e-17, r);
          const double r2 = r * r;
          const double sn = r * (1.0 + r2 * (-1.0 / 6 + r2 * (1.0 / 120 + r2 * (-1.0 / 5040 + r2 * (1.0 / 362880 + r2 * (-1.0 / 39916800 + r2 * (1.0 / 6227020800.0)))))));
          const double cs = 1.0 + r2 * (-0.5 + r2 * (1.0 / 24 + r2 * (-1.0 / 720 + r2 * (1.0 / 40320 + r2 * (-1.0 / 3628800 + r2 * (1.0 / 479001600.0 + r2 * (-1.0 / 87178291200.0)))))));
          const int q = (int)((long long)k & 3); double c, s;
          if (q == 0) { c = cs; s = sn; } else if (q == 1) { c = -sn; s = cs; } else if (q == 2) { c = -cs; s = -sn; } else { c = sn; s = -cs; }
          rot[(size_t)slot * 128 + i] = (float)c; rot[(size_t)slot * 128 + 64 + i] = (float)s; } }
    if (gw == 0) { float* lam = (float*)(a.ws + WS_LAM);
        for (int l = 0; l < DEPTH; ++l) { const float s1 = wave_sum(a.in[13][l * 64 + lane] * a.in[14][l * 64 + lane]), s2 = wave_sum(a.in[15][l * 64 + lane] * a.in[16][l * 64 + lane]);
            const float li0 = 0.8f - 0.6f * expf(-0.3f * (float)l);
            if (lane == 0) { lam[2 * l] = expf(s1) - expf(s2) + li0; lam[2 * l + 1] = 1.0f - li0; } } }
}

__global__ void __launch_bounds__(NWAVES * 64, 2) mk_fwd(Args args) {
    extern __shared__ __attribute__((aligned(16))) unsigned char lds_raw[];
    LAS unsigned char* lds = (LAS unsigned char*)lds_raw;
    volatile LAS unsigned* MISC = (volatile LAS unsigned*)(lds + MISC_OFF);
    const int tid = threadIdx.x, lane = tid & 63, wave = __builtin_amdgcn_readfirstlane(tid >> 6);
    const int G = gridDim.x, bx = blockIdx.x;
    unsigned* ctl = (unsigned*)(args.ws + WS_CTL);
    for (int u = tid; u < 64; u += NWAVES * 64) MISC[u] = 0u;
    __syncthreads();
    XcdBarrier bar; bar.bar = ctl + CW_BAR; bar.x = 0; bar.st = nullptr;
    if (!MK_PER_PHASE) bar = xcd_barrier_post(ctl + CW_BAR, MISC + 8);
    const int lo = args.ph_lo, hi = args.ph_hi;
#define IN(k) (lo <= (k) && (k) < hi)
#define SEAM(k) do { if (IN((k) + 1)) xcd_barrier(bar); } while (0)
#define OPQ() int G_ = gridDim.x, bx_ = blockIdx.x; asm volatile("" : "+s"(G_), "+s"(bx_))
#define WSB(off) ((bf16*)(args.ws + (off)))
#define SSP(i) ((float*)(args.ws + WS_CTL) + CW_SS + (size_t)(i) * TT)
#define YP (args.out + OUT_Y)
#define WL(off) (WSB(WS_W) + (size_t)l * LAYER_W + (off))
    if (IN(0)) { int tid_o = threadIdx.x; asm volatile("" : "+v"(tid_o)); const int w_ = __builtin_amdgcn_readfirstlane(tid_o >> 6); p0_prologue(args, lds, bx * NWAVES + w_, G * NWAVES, tid_o & 63, w_); SEAM(0); }

    for (int l = 0; l < DEPTH; ++l) {
        const int pb = 1 + 9 * l;
        if (IN(pb + 0)) { OPQ(); pg8::Gemm g{WSB(WS_XB), WL(O_WGU1), TT, NPROJ, 2048}; pg8::StaticOrder S; S.init(TT, NPROJ, G_, bx_);
            pg8::EpiSwiglu E{WSB(WS_HID), SSP(3 * l)}; pg8::gemm_phase<pg8::EpiSwiglu, pg8::StaticOrder, true, true>(lds, g, S, E); SEAM(pb + 0); }
        if (IN(pb + 1)) { OPQ(); pg8::Gemm g{WSB(WS_HID), WL(O_WD1), TT, 2048, 5632}; pg8::StaticOrder S; S.init(TT, 2048, G_, bx_);
            pg8::EpiResid E{l == 0 ? args.in[0] : YP, l == 0 ? args.in[1] - (size_t)T_P * 2048 : YP, YP, WSB(WS_XB), SSP(3 * l + 1), 0.5f};
            pg8::gemm_phase<pg8::EpiResid, pg8::StaticOrder, true, true>(lds, g, S, E); SEAM(pb + 1); }
        if (IN(pb + 2)) { OPQ(); pg8::Gemm g{WSB(WS_XB), WL(O_WIN), TT, NPROJ, 2048}; pg8::StaticOrder S; S.init(TT, NPROJ, G_, bx_);
            pg8::EpiProj E{SSP(3 * l + 1), (const float*)(args.ws + WS_ROT), args.in[11] + l * 64, args.in[12] + l * 64, WSB(WS_RQ), WSB(WS_RK), WSB(WS_RV), WSB(WS_RG), WSB(WS_DQ), WSB(WS_DK), WSB(WS_DV), WSB(WS_GR), WSB(WS_GD),
                           args.out + OUT_KP + (size_t)l * T_P * 1024, args.out + OUT_VP + (size_t)l * T_P * 1024, args.out + OUT_KS + (size_t)l * T_S * 1024, args.out + OUT_VS + (size_t)l * T_S * 1024};
            pg8::gemm_phase<pg8::EpiProj, pg8::StaticOrder, true, true>(lds, g, S, E); SEAM(pb + 2); }
        if (IN(pb + 3) || IN(pb + 4)) {
            const float* lamp = (const float*)(args.ws + WS_LAM);
            mix::AttnP AP{WSB(WS_DQ), WSB(WS_DK), WSB(WS_DV), args.in[2] + (size_t)l * NB * PAST * 1024, args.in[3] + (size_t)l * NB * PAST * 1024,
                          args.out + OUT_KS + (size_t)l * T_S * 1024, args.out + OUT_VS + (size_t)l * T_S * 1024, WSB(WS_DO), (float*)(args.ws + WS_PART), args.in[25], args.in[17] + l * 128, __uint_as_float(__builtin_amdgcn_readfirstlane(__float_as_uint(lamp[2 * l]))), __uint_as_float(__builtin_amdgcn_readfirstlane(__float_as_uint(lamp[2 * l + 1])))};
            if (IN(pb + 3)) { OPQ();
                for (int p = bx_; p < 1024; p += G_) { const int pp = p & 511, bh = pp >> 3, j = pp & 7;
                    mix::attn_unit<false>(lds, AP, bh >> 3, bh & 7, p < 512 ? 15 - j : j); }
                for (int s = bx_; s < 256; s += G_) mix::attn_unit<true>(lds, AP, s >> 5, (s >> 2) & 7, s & 3);
                mix::RetP RP{WSB(WS_RQ), WSB(WS_RK), WSB(WS_RV), WSB(WS_RG), WSB(WS_RO), args.in[4] + (size_t)l * 64 * 16384, args.out + OUT_RP + (size_t)l * 64 * 16384, args.out + OUT_RS + (size_t)l * 64 * 16384};
                for (int r = bx_; r < 128; r += G_) mix::ret_unit(lds, RP, r >= 64, (r & 63) >> 3, r & 7);
                SEAM(pb + 3); }
            if (IN(pb + 4)) { OPQ(); for (int s = bx_; s < 64; s += G_) mix::attn_merge_unit(lds, AP, s >> 3, s & 7); SEAM(pb + 4); }
        }
        if (IN(pb + 5)) { OPQ(); pg8::StaticOrder S; S.init(TT, 2048, G_, bx_);
            { pg8::Gemm g{WSB(WS_RO), WL(O_WR), TT, 2048, 1024}; pg8::EpiGate<0> E{WSB(WS_GR), WSB(WS_MRG)}; pg8::gemm_phase<pg8::EpiGate<0>, pg8::StaticOrder, true, true>(lds, g, S, E); }
            { pg8::Gemm g{WSB(WS_DO), WL(O_WDU), TT, 2048, 1024}; pg8::EpiGate<1> E{WSB(WS_GD), WSB(WS_MRG)}; pg8::gemm_phase<pg8::EpiGate<1>, pg8::StaticOrder, true, true>(lds, g, S, E); }
            SEAM(pb + 5); }
        if (IN(pb + 6)) { OPQ(); pg8::Gemm g{WSB(WS_MRG), WL(O_WO), TT, 2048, 2048}; pg8::StaticOrder S; S.init(TT, 2048, G_, bx_);
            pg8::EpiResid E{YP, YP, YP, WSB(WS_XB), SSP(3 * l + 2), 1.0f}; pg8::gemm_phase<pg8::EpiResid, pg8::StaticOrder, true, true>(lds, g, S, E); SEAM(pb + 6); }
        if (IN(pb + 7)) { OPQ(); pg8::Gemm g{WSB(WS_XB), WL(O_WGU2), TT, NPROJ, 2048}; pg8::StaticOrder S; S.init(TT, NPROJ, G_, bx_);
            pg8::EpiSwiglu E{WSB(WS_HID), SSP(3 * l + 2)}; pg8::gemm_phase<pg8::EpiSwiglu, pg8::StaticOrder, true, true>(lds, g, S, E); SEAM(pb + 7); }
        if (IN(pb + 8)) { OPQ(); pg8::Gemm g{WSB(WS_HID), WL(O_WD2), TT, 2048, 5632}; pg8::StaticOrder S; S.init(TT, 2048, G_, bx_);
            pg8::EpiResid E{YP, YP, YP, WSB(WS_XB), SSP(3 * l + 3), 0.5f}; pg8::gemm_phase<pg8::EpiResid, pg8::StaticOrder, true, true>(lds, g, S, E); SEAM(pb + 8); }
    }
#undef IN
#undef SEAM
}

extern "C" void kernel_launch(void* const* d_in, const int* in_sizes, int n_in, void* d_out, int out_size, void* d_ws, size_t ws_size, hipStream_t stream) {
    static int grid = 0;
    if (grid == 0) {
        if (n_in != 26 || out_size != (int)OUT_END || ws_size < WS_END) { fprintf(stderr, "kernel_launch: unexpected shapes: n_in %d out %d ws %zu (need %zu)\n", n_in, out_size, ws_size, (size_t)WS_END); grid = -1; return; }
        int dev = 0, cus = 0, per_cu = 0;
        if (hipGetDevice(&dev) != hipSuccess || hipDeviceGetAttribute(&cus, hipDeviceAttributeMultiprocessorCount, dev) != hipSuccess) { grid = -1; return; }
        if (hipFuncSetAttribute((const void*)mk_fwd, hipFuncAttributeMaxDynamicSharedMemorySize, LDS_BYTES) != hipSuccess) { fprintf(stderr, "kernel_launch: hipFuncSetAttribute failed\n"); grid = -1; return; }
        if (hipOccupancyMaxActiveBlocksPerMultiprocessor(&per_cu, (const void*)mk_fwd, NWAVES * 64, LDS_BYTES) != hipSuccess || per_cu < 1) fprintf(stderr, "kernel_launch: occupancy query says %d\n", per_cu);
        (void)hipGetLastError();
        grid = cus;
    }
    if (grid < 0) return;
    (void)hipMemsetAsync((char*)d_ws + WS_CTL, 0, CTL_ZERO_BYTES, stream);
    Args a{};
    for (int i = 0; i < 26; ++i) a.in[i] = (const float*)d_in[i];
    a.out = (float*)d_out; a.ws = (unsigned char*)d_ws;
#if MK_PER_PHASE
    for (int p = 0; p < NPHASE; ++p) { a.ph_lo = p; a.ph_hi = p + 1; hipLaunchKernelGGL(mk_fwd, dim3(grid), dim3(NWAVES * 64), LDS_BYTES, stream, a); }
#else
    a.ph_lo = 0; a.ph_hi = NPHASE; hipLaunchKernelGGL(mk_fwd, dim3(grid), dim3(NWAVES * 64), LDS_BYTES, stream, a);
#endif
}
```

```cpp
#include <hip/hip_runtime.h>
#include <cstdio>
#include <cstdint>

constexpr int DM = 2048, T_P = 16384, T_S = 512, TT = 16896, DFF = 5632, NPROJ = 11264, DEPTH = 2;
constexpr int SEQ = 2048, DSEQ = 64, PAST = 4096, NB = 8, NH = 8;
constexpr float EPS = 1e-6f;
constexpr float LOG2E = 1.4426950408889634f;
constexpr float QSCALE = 0.125f * LOG2E;
constexpr float RK_SCALE = 0.08838834764831845f;
namespace pg8 {
#define PG8_LAS __attribute__((address_space(3)))
typedef unsigned short bf16_t;
typedef short bf16x8 __attribute__((ext_vector_type(8)));
typedef float f32x4 __attribute__((ext_vector_type(4)));
typedef unsigned u32x4 __attribute__((ext_vector_type(4)));
constexpr int BM = 256, BK = 64, HALF = 128, HTB = HALF * BK * 2  , STAGE_BYTES = 8 * HTB, NXCD = 8, WGM = 8;

__host__ __device__ __forceinline__ int lds_byte(int r, int c) { const int st = (r >> 4) * 2 + (c >> 5), rr = r & 15, cc = c & 31, ob = rr * 64 + cc * 2; return st * 1024 + (ob ^ (((ob >> 9) & 1) << 5)); }
__host__ __device__ __forceinline__ void stage_rc(int b, int& R, int& C) { const int st = b / 1024, sb = b % 1024, swz = sb ^ (((sb >> 9) & 1) << 5); R = (st >> 1) * 16 + swz / 64; C = (st & 1) * 32 + (swz % 64) / 2; }
__host__ __device__ __forceinline__ int perm32(int rho) { const int n = rho >> 4, i = rho & 15; return 8 * (i >> 2) + 4 * n + (i & 3); }

struct Unit { int pm, pn; };
struct Gemm { const bf16_t* A; const bf16_t* Bt; int M, N, K; };

struct StaticOrder {
    int nM, nN, nwg, G, c;
    __host__ __device__ void init(int M, int N, int G_, int c_) { nM = M / BM; nN = N / BM; nwg = nM * nN; G = G_; c = c_; }
    __host__ __device__ bool next(int i, Unit& u) const {
        const long L = (long)i * G + c; if (L >= nwg) return false;
        int wgid = (int)L; { const int q = nwg / NXCD, r = nwg % NXCD, xcd = wgid % NXCD, off = wgid / NXCD; wgid = (xcd < r ? xcd * (q + 1) : r * (q + 1) + (xcd - r) * q) + off; }
        const int nig = WGM * nN, gid = wgid / nig, fm = gid * WGM, gsz = (nM - fm) < WGM ? (nM - fm) : WGM;
        u.pm = fm + ((wgid % nig) % gsz); u.pn = (wgid % nig) / gsz; return true;
    }
    __device__ __forceinline__ void a_ready(const Unit&) const {}
    __device__ __forceinline__ void done(const Unit&) const {}
};

__device__ __forceinline__ unsigned cvt_pk_bf16(float lo, float hi) { unsigned r; asm volatile("v_cvt_pk_bf16_f32 %0, %1, %2" : "=v"(r) : "v"(lo), "v"(hi)); return r; }
typedef float f32x2 __attribute__((ext_vector_type(2)));
typedef unsigned u32x2 __attribute__((ext_vector_type(2)));
__device__ __forceinline__ float silu_f(float x) { return x * __builtin_amdgcn_rcpf(1.0f + __builtin_amdgcn_exp2f(-x * 1.4426950408889634f)); }
__device__ __forceinline__ float sigm_f(float x) { return __builtin_amdgcn_rcpf(1.0f + __builtin_amdgcn_exp2f(-x * 1.4426950408889634f)); }
__device__ __forceinline__ float rinv_of(const float* ss, int row) { return rsqrtf(ss[row] * (1.0f / 2048.0f) + 1e-6f); }

struct EpiSwiglu {
    static constexpr bool PERM = true, AFTER_DRAIN = false;
    bf16_t* H; const float* ss;
    __device__ __forceinline__ void operator()(const f32x4 (&acc)[2][2][4][2], const Unit& u, int wr, int wc, int fr, int fq) const {
        const int row0 = u.pm * BM + wr * 64 + fr, col0 = u.pn * 128 + wc * 32 + 8 * fq;
#pragma unroll
        for (int ai = 0; ai < 2; ++ai)
#pragma unroll
            for (int m = 0; m < 4; ++m) { const int row = row0 + ai * HALF + m * 16; const float r = rinv_of(ss, row);
                float o[8];
#pragma unroll
                for (int n = 0; n < 2; ++n)
#pragma unroll
                    for (int e = 0; e < 4; ++e) { const float g = acc[ai][0][m][n][e] * r, up = acc[ai][1][m][n][e] * r; o[4 * n + e] = silu_f(g) * up; }
                u32x4 w; w.x = cvt_pk_bf16(o[0], o[1]); w.y = cvt_pk_bf16(o[2], o[3]); w.z = cvt_pk_bf16(o[4], o[5]); w.w = cvt_pk_bf16(o[6], o[7]);
                *(u32x4*)(H + (size_t)row * 5632 + col0) = w; }
    }
};

struct EpiResid {
    static constexpr bool PERM = false, AFTER_DRAIN = false;
    const float* baseP; const float* baseS; float* Y; bf16_t* XB; float* ssn; float alpha;
    __device__ __forceinline__ void operator()(const f32x4 (&acc)[2][2][4][2], const Unit& u, int wr, int wc, int fr, int fq) const {
        const int row0 = u.pm * BM + wr * 64 + fr, col0 = u.pn * BM + wc * 32 + 4 * fq;
        const float* base = (u.pm < 64) ? baseP : baseS;
#pragma unroll
        for (int ai = 0; ai < 2; ++ai)
#pragma unroll
            for (int m = 0; m < 4; ++m) { const int row = row0 + ai * HALF + m * 16; const size_t off = (size_t)row * 2048 + col0; float sq = 0.f;
#pragma unroll
                for (int bj = 0; bj < 2; ++bj)
#pragma unroll
                    for (int n = 0; n < 2; ++n) { const f32x4 b = *(const f32x4*)(base + off + bj * HALF + n * 16); const f32x4 o = b + acc[ai][bj][m][n] * alpha;
                        *(f32x4*)(Y + off + bj * HALF + n * 16) = o; sq += (o[0] * o[0] + o[1] * o[1]) + (o[2] * o[2] + o[3] * o[3]);
                        u32x2 w; w.x = cvt_pk_bf16(o[0], o[1]); w.y = cvt_pk_bf16(o[2], o[3]); *(u32x2*)(XB + off + bj * HALF + n * 16) = w; }
                sq += __shfl_xor(sq, 16); sq += __shfl_xor(sq, 32);
                if (fq == 0) unsafeAtomicAdd(ssn + row, sq); }
    }
};

template <int PASS> struct EpiGate {
    static constexpr bool PERM = true, AFTER_DRAIN = false;
    const bf16_t* G; bf16_t* MRG;
    __device__ __forceinline__ void operator()(const f32x4 (&acc)[2][2][4][2], const Unit& u, int wr, int wc, int fr, int fq) const {
        const int row0 = u.pm * BM + wr * 64 + fr, col0 = u.pn * BM + wc * 32 + 8 * fq;
#pragma unroll
        for (int ai = 0; ai < 2; ++ai)
#pragma unroll
            for (int m = 0; m < 4; ++m) { const size_t off = (size_t)(row0 + ai * HALF + m * 16) * 2048 + col0;
#pragma unroll
                for (int bj = 0; bj < 2; ++bj) { const u32x4 g = *(const u32x4*)(G + off + bj * HALF); u32x4 p = (u32x4){0u, 0u, 0u, 0u}; if (PASS == 1) p = *(const u32x4*)(MRG + off + bj * HALF);
                    float o[8];
#pragma unroll
                    for (int q = 0; q < 4; ++q) { const float g0 = __uint_as_float(g[q] << 16), g1 = __uint_as_float(g[q] & 0xffff0000u), p0 = __uint_as_float(p[q] << 16), p1 = __uint_as_float(p[q] & 0xffff0000u);
                        const f32x4 a = acc[ai][bj][m][q >> 1]; o[2 * q] = p0 + g0 * a[(2 * q) & 3]; o[2 * q + 1] = p1 + g1 * a[(2 * q + 1) & 3]; }
                    u32x4 w; w.x = cvt_pk_bf16(o[0], o[1]); w.y = cvt_pk_bf16(o[2], o[3]); w.z = cvt_pk_bf16(o[4], o[5]); w.w = cvt_pk_bf16(o[6], o[7]);
                    *(u32x4*)(MRG + off + bj * HALF) = w; } }
    }
};

struct EpiProj {
    static constexpr bool PERM = true, AFTER_DRAIN = false;
    const float* ss; const float* rot;
    const float* qg; const float* kg;
    bf16_t *RQ, *RK, *RV, *RG, *DQ, *DK, *DV, *GR, *GD;
    float *KP, *VP, *KS, *VS;
    __device__ __forceinline__ void operator()(const f32x4 (&acc)[2][2][4][2], const Unit& u, int wr, int wc, int fr, int fq) const {
        const int row0 = u.pm * BM + wr * 64 + fr; const int seg = u.pn >> 2, t4 = u.pn & 3;
        if (seg <= 1) {
            bf16_t* O = seg == 0 ? RQ : RK; const float sc = seg == 0 ? 1.0f : 0.08838834764831845f; const int o = 16 * wc + 4 * fq;
#pragma unroll
            for (int ai = 0; ai < 2; ++ai)
#pragma unroll
                for (int m = 0; m < 4; ++m) { const int row = row0 + ai * HALF + m * 16; const float r = rinv_of(ss, row) * sc;
                    const int slot = row < 16384 ? (row & 2047) : 2048 + (row & 63);
                    const f32x4 cs = *(const f32x4*)(rot + (size_t)slot * 128 + o), sn = *(const f32x4*)(rot + (size_t)slot * 128 + 64 + o);
#pragma unroll
                    for (int bj = 0; bj < 2; ++bj) { const f32x4 x1 = acc[ai][bj][m][0] * r, x2 = acc[ai][bj][m][1] * r; const f32x4 y1 = x1 * cs - x2 * sn, y2 = x1 * sn + x2 * cs;
                        bf16_t* p = O + (size_t)row * 1024 + (2 * t4 + bj) * 128 + o; u32x2 w1, w2; w1.x = cvt_pk_bf16(y1[0], y1[1]); w1.y = cvt_pk_bf16(y1[2], y1[3]); w2.x = cvt_pk_bf16(y2[0], y2[1]); w2.y = cvt_pk_bf16(y2[2], y2[3]);
                        *(u32x2*)p = w1; *(u32x2*)(p + 64) = w2; } }
        } else if (seg == 4 || seg == 5) {
            const float* gn = seg == 4 ? qg : kg; bf16_t* O = seg == 4 ? DQ : DK; const float sc = seg == 4 ? QSCALE : 1.0f;
            f32x4 gv[2][2];
#pragma unroll
            for (int bj = 0; bj < 2; ++bj)
#pragma unroll
                for (int n = 0; n < 2; ++n) gv[bj][n] = *(const f32x4*)(gn + 32 * bj + 8 * fq + 4 * n) * sc;
#pragma unroll
            for (int ai = 0; ai < 2; ++ai)
#pragma unroll
                for (int m = 0; m < 4; ++m) { const int row = row0 + ai * HALF + m * 16; const float r = rinv_of(ss, row); f32x4 v[2][2]; float sq = 0.f;
#pragma unroll
                    for (int bj = 0; bj < 2; ++bj)
#pragma unroll
                        for (int n = 0; n < 2; ++n) { v[bj][n] = acc[ai][bj][m][n] * r; sq += (v[bj][n][0] * v[bj][n][0] + v[bj][n][1] * v[bj][n][1]) + (v[bj][n][2] * v[bj][n][2] + v[bj][n][3] * v[bj][n][3]); }
                    sq += __shfl_xor(sq, 16); sq += __shfl_xor(sq, 32);
                    const float rr = rsqrtf(sq * (1.0f / 64.0f) + 1e-6f);
                    const int col = t4 * 256 + 64 * wc + 8 * fq;
                    float* kout = nullptr; if (seg == 5) kout = row < 16384 ? KP + (size_t)row * 1024 : KS + (size_t)(row - 16384) * 1024;
#pragma unroll
                    for (int bj = 0; bj < 2; ++bj) { const f32x4 a = v[bj][0] * rr * gv[bj][0], b = v[bj][1] * rr * gv[bj][1];
                        u32x4 w; w.x = cvt_pk_bf16(a[0], a[1]); w.y = cvt_pk_bf16(a[2], a[3]); w.z = cvt_pk_bf16(b[0], b[1]); w.w = cvt_pk_bf16(b[2], b[3]);
                        *(u32x4*)(O + (size_t)row * 1024 + col + 32 * bj) = w;
                        if (seg == 5) { *(f32x4*)(kout + col + 32 * bj) = a; *(f32x4*)(kout + col + 32 * bj + 4) = b; } } }
        } else {
            bf16_t* O; int ld, cb; int act = 0;
            if (seg == 2) { O = RV; ld = 1024; cb = t4 * 256; } else if (seg == 3) { O = RG; ld = 1024; cb = t4 * 256; act = 1; } else if (seg == 6) { O = DV; ld = 1024; cb = t4 * 256; }
            else if (seg <= 8) { O = GR; ld = 2048; cb = (u.pn - 28) * 256; act = 2; } else { O = GD; ld = 2048; cb = (u.pn - 36) * 256; act = 2; }
            const int col = cb + wc * 32 + 8 * fq;
#pragma unroll
            for (int ai = 0; ai < 2; ++ai)
#pragma unroll
                for (int m = 0; m < 4; ++m) { const int row = row0 + ai * HALF + m * 16; const float r = rinv_of(ss, row);
                    float* vout = nullptr; if (seg == 6) vout = row < 16384 ? VP + (size_t)row * 1024 : VS + (size_t)(row - 16384) * 1024;
#pragma unroll
                    for (int bj = 0; bj < 2; ++bj) { f32x4 a = acc[ai][bj][m][0] * r, b = acc[ai][bj][m][1] * r;
                        if (act == 1) { for (int e = 0; e < 4; ++e) { a[e] = silu_f(a[e]); b[e] = silu_f(b[e]); } }
                        if (act == 2) { for (int e = 0; e < 4; ++e) { a[e] = sigm_f(a[e]); b[e] = sigm_f(b[e]); } }
                        u32x4 w; w.x = cvt_pk_bf16(a[0], a[1]); w.y = cvt_pk_bf16(a[2], a[3]); w.z = cvt_pk_bf16(b[0], b[1]); w.w = cvt_pk_bf16(b[2], b[3]);
                        *(u32x4*)(O + (size_t)row * ld + col + bj * HALF) = w;
                        if (seg == 6) { *(f32x4*)(vout + col + bj * HALF) = a; *(f32x4*)(vout + col + bj * HALF + 4) = b; } } }
        }
    }
};

template <class Epi, class Sched, bool ALIGN_EPI = false, bool SP2 = false>
__device__ __forceinline__ void gemm_phase(PG8_LAS unsigned char* lds, const Gemm g, const Sched& S, const Epi& E) {
    int tid_o = threadIdx.x; asm volatile("" : "+v"(tid_o));
    const int tid = tid_o, wid = __builtin_amdgcn_readfirstlane(tid >> 6), lane = tid & 63, wr = wid >> 2, wc = wid & 3, fr = lane & 15, fq = lane >> 4;
    const int K = g.K, nt = K / BK;
    unsigned voffA[2], voffB[2];
#pragma unroll
    for (int i = 0; i < 2; ++i) { int R, C; stage_rc(tid * 16 + i * 8192, R, C); const int Rb = Epi::PERM ? ((R & ~31) + perm32(R & 31)) : R;
        voffA[i] = (unsigned)(R * K + C) * 2u; voffB[i] = (unsigned)(Rb * K + C) * 2u; }
    const size_t kstep = (size_t)(BK * 2);
    const size_t hstep = (size_t)HALF * K * 2;
    const size_t tstep = 2 * hstep;
    const unsigned ldsw = (unsigned)wid * 1024u;
    const int aoff = lds_byte(wr * 64 + fr, fq * 8), boff = lds_byte(wc * 32 + fr, fq * 8);
#define PG8_SA(b, h) (((b) * 2 + (h)) * HTB)
#define PG8_SB(b, h) ((4 + (b) * 2 + (h)) * HTB)
#define PG8_STAGE(bufoff, gbase, voff) do { _Pragma("unroll") for (int _i = 0; _i < 2; ++_i) \
        __builtin_amdgcn_global_load_lds((const unsigned*)((const char*)(gbase) + (voff)[_i]), (PG8_LAS unsigned*)(lds + (bufoff) + ldsw + _i * 8192), 16, 0, 0); } while (0)
#define PG8_LDA(dst, b, h) do { _Pragma("unroll") for (int m = 0; m < 4; ++m) _Pragma("unroll") for (int k = 0; k < 2; ++k) dst[m][k] = *(const PG8_LAS bf16x8*)(lds + PG8_SA(b, h) + aoff + m * 2048 + k * 1024); } while (0)
#define PG8_LDB(dst, b, h) do { _Pragma("unroll") for (int n = 0; n < 2; ++n) _Pragma("unroll") for (int k = 0; k < 2; ++k) dst[n][k] = *(const PG8_LAS bf16x8*)(lds + PG8_SB(b, h) + boff + n * 2048 + k * 1024); } while (0)
#define PG8_MMA(ai, bj, At, Bt) do { __builtin_amdgcn_s_setprio(1); _Pragma("unroll") for (int m = 0; m < 4; ++m) _Pragma("unroll") for (int n = 0; n < 2; ++n) _Pragma("unroll") for (int k = 0; k < 2; ++k) \
        acc[ai][bj][m][n] = __builtin_amdgcn_mfma_f32_16x16x32_bf16(Bt[n][k], At[m][k], acc[ai][bj][m][n], 0, 0, 0); __builtin_amdgcn_s_setprio(0); } while (0)
#define PG8_WAIT_V(n) asm volatile("s_waitcnt vmcnt(" #n ")" ::: "memory")
#define PG8_WAIT_L(n) asm volatile("s_waitcnt lgkmcnt(" #n ")" ::: "memory")
#define PG8_BAR __builtin_amdgcn_s_barrier()
#define PG8_SCHED __builtin_amdgcn_sched_barrier(0)
    Unit cur, nxt; int ui = 0;
    if (!S.next(0, cur)) return;
    f32x4 acc[2][2][4][2];
#pragma unroll
    for (int a = 0; a < 2; ++a)
#pragma unroll
        for (int b = 0; b < 2; ++b)
#pragma unroll
            for (int m = 0; m < 4; ++m)
#pragma unroll
                for (int n = 0; n < 2; ++n) acc[a][b][m][n] = (f32x4){0.f, 0.f, 0.f, 0.f};
    bf16x8 At[4][2], B0[2][2], B1[2][2];
    const char* cA = (const char*)g.A + (size_t)cur.pm * tstep; const char* cB = (const char*)g.Bt + (size_t)cur.pn * tstep;
    S.a_ready(cur);
    if constexpr (SP2) {
        PG8_STAGE(PG8_SB(0, 0), cB, voffB); PG8_STAGE(PG8_SB(0, 1), cB + hstep, voffB); PG8_STAGE(PG8_SA(0, 0), cA, voffA); PG8_STAGE(PG8_SA(0, 1), cA + hstep, voffA);
        if (wr == 1) PG8_BAR;
        PG8_WAIT_V(2); PG8_BAR;
        PG8_STAGE(PG8_SB(1, 0), cB + kstep, voffB); PG8_STAGE(PG8_SA(1, 0), cA + kstep, voffA); PG8_STAGE(PG8_SB(1, 1), cB + hstep + kstep, voffB);
        PG8_WAIT_V(6); PG8_BAR;
    } else {
        PG8_STAGE(PG8_SB(0, 0), cB, voffB); PG8_STAGE(PG8_SA(0, 0), cA, voffA); PG8_STAGE(PG8_SB(0, 1), cB + hstep, voffB); PG8_STAGE(PG8_SA(0, 1), cA + hstep, voffA);
        if (wr == 1) PG8_BAR;
        PG8_WAIT_V(4); PG8_BAR;
        PG8_STAGE(PG8_SB(1, 0), cB + kstep, voffB); PG8_STAGE(PG8_SA(1, 0), cA + kstep, voffA); PG8_STAGE(PG8_SB(1, 1), cB + hstep + kstep, voffB);
        PG8_WAIT_V(6); PG8_BAR;
    }
    for (;;) {
        const bool has_next = S.next(ui + 1, nxt);
        const char* nA = has_next ? (const char*)g.A + (size_t)nxt.pm * tstep : cA; const char* nB = has_next ? (const char*)g.Bt + (size_t)nxt.pn * tstep : cB;
        for (int t = 0; t < nt; t += 2) {
            const bool last = (t == nt - 2);
            const char* a1 = cA + (size_t)(t + 1) * kstep;
            const char* a2 = last ? nA : cA + (size_t)(t + 2) * kstep; const char* b2 = last ? nB : cB + (size_t)(t + 2) * kstep;
            const char* a3 = a2 + kstep; const char* b3 = b2 + kstep;
            if (last && has_next) S.a_ready(nxt);
            if constexpr (SP2) {
            PG8_LDB(B0, 0, 0); PG8_LDB(B1, 0, 1); PG8_SCHED; PG8_LDA(At, 0, 0); PG8_STAGE(PG8_SA(1, 1), a1 + hstep, voffA);
            PG8_WAIT_V(8); PG8_WAIT_L(0); PG8_BAR; PG8_MMA(0, 0, At, B0); PG8_MMA(0, 1, At, B1); PG8_BAR; PG8_SCHED;
            PG8_LDA(At, 0, 1); PG8_STAGE(PG8_SB(0, 0), b2, voffB); PG8_STAGE(PG8_SB(0, 1), b2 + hstep, voffB); PG8_STAGE(PG8_SA(0, 0), a2, voffA);
            PG8_WAIT_V(8); PG8_WAIT_L(0); PG8_BAR; PG8_MMA(1, 0, At, B0); PG8_MMA(1, 1, At, B1); PG8_BAR; PG8_SCHED;
            PG8_LDB(B0, 1, 0); PG8_LDB(B1, 1, 1); PG8_SCHED; PG8_LDA(At, 1, 0); PG8_STAGE(PG8_SA(0, 1), a2 + hstep, voffA);
            PG8_WAIT_V(8); PG8_WAIT_L(0); PG8_BAR; PG8_MMA(0, 0, At, B0); PG8_MMA(0, 1, At, B1); PG8_BAR; PG8_SCHED;
            PG8_LDA(At, 1, 1); PG8_STAGE(PG8_SB(1, 0), b3, voffB); PG8_STAGE(PG8_SB(1, 1), b3 + hstep, voffB); PG8_STAGE(PG8_SA(1, 0), a3, voffA);
            PG8_WAIT_V(8); PG8_WAIT_L(0); PG8_BAR; PG8_MMA(1, 0, At, B0); PG8_MMA(1, 1, At, B1); PG8_BAR; PG8_SCHED;
            } else {
            PG8_LDB(B0, 0, 0); PG8_SCHED; PG8_LDA(At, 0, 0); PG8_STAGE(PG8_SA(1, 1), a1 + hstep, voffA);
            PG8_WAIT_L(8); PG8_BAR; PG8_WAIT_L(0); PG8_MMA(0, 0, At, B0); PG8_BAR; PG8_SCHED;
            PG8_LDB(B1, 0, 1); PG8_STAGE(PG8_SB(0, 0), b2, voffB);
            PG8_BAR; PG8_WAIT_L(0); PG8_MMA(0, 1, At, B1); PG8_BAR;
            PG8_LDA(At, 0, 1); PG8_STAGE(PG8_SA(0, 0), a2, voffA);
            PG8_BAR; PG8_WAIT_L(0); PG8_MMA(1, 0, At, B0); PG8_BAR; PG8_SCHED;
            PG8_STAGE(PG8_SB(0, 1), b2 + hstep, voffB);
            PG8_WAIT_V(6); PG8_BAR; PG8_MMA(1, 1, At, B1); PG8_BAR;
            PG8_LDB(B0, 1, 0); PG8_SCHED; PG8_LDA(At, 1, 0); PG8_STAGE(PG8_SA(0, 1), a2 + hstep, voffA);
            PG8_WAIT_L(8); PG8_BAR; PG8_WAIT_L(0); PG8_MMA(0, 0, At, B0); PG8_BAR; PG8_SCHED;
            PG8_LDB(B1, 1, 1); PG8_STAGE(PG8_SB(1, 0), b3, voffB);
            PG8_BAR; PG8_WAIT_L(0); PG8_MMA(0, 1, At, B1); PG8_BAR;
            PG8_LDA(At, 1, 1); PG8_STAGE(PG8_SA(1, 0), a3, voffA);
            PG8_BAR; PG8_WAIT_L(0); PG8_MMA(1, 0, At, B0); PG8_BAR; PG8_SCHED;
            PG8_STAGE(PG8_SB(1, 1), b3 + hstep, voffB);
            PG8_WAIT_V(6); PG8_BAR; PG8_MMA(1, 1, At, B1); PG8_BAR;
            }
        }
        if constexpr (ALIGN_EPI) { if (wr == 0) PG8_BAR; }
        if constexpr (!Epi::AFTER_DRAIN) { E(acc, cur, wr, wc, fr, fq); S.done(cur); }
        if (!has_next) break;
#pragma unroll
        for (int a = 0; a < 2; ++a)
#pragma unroll
            for (int b = 0; b < 2; ++b)
#pragma unroll
                for (int m = 0; m < 4; ++m)
#pragma unroll
                    for (int n = 0; n < 2; ++n) acc[a][b][m][n] = (f32x4){0.f, 0.f, 0.f, 0.f};
        cur = nxt; cA = nA; cB = nB; ++ui;
        if constexpr (ALIGN_EPI) { if (wr == 1) PG8_BAR; }
    }
    PG8_WAIT_V(0);
    if constexpr (!ALIGN_EPI) { if (wr == 0) PG8_BAR; }
    PG8_BAR;
    if constexpr (Epi::AFTER_DRAIN) { E.fused(acc, cur, wr, wc, fr, fq, lds, wid, lane); S.done(cur); }
#undef PG8_SA
#undef PG8_SB
#undef PG8_STAGE
#undef PG8_LDA
#undef PG8_LDB
#undef PG8_MMA
#undef PG8_WAIT_V
#undef PG8_WAIT_L
#undef PG8_BAR
#undef PG8_SCHED
}
}

namespace mix {
#define LAS __attribute__((address_space(3)))
typedef unsigned short bf16_t;
typedef short bf16x8 __attribute__((ext_vector_type(8)));
typedef short s16x4 __attribute__((ext_vector_type(4)));
typedef float f32x4 __attribute__((ext_vector_type(4)));
typedef float f32x16 __attribute__((ext_vector_type(16)));
typedef unsigned u32x4 __attribute__((ext_vector_type(4)));
typedef unsigned u32x2 __attribute__((ext_vector_type(2)));
#define SBAR() __builtin_amdgcn_sched_barrier(0)
__device__ __forceinline__ int crow(int r, int hi) { return (r & 3) + 8 * (r >> 2) + 4 * hi; }
__device__ __forceinline__ unsigned cvtpk(float lo, float hi) { unsigned r; asm volatile("v_cvt_pk_bf16_f32 %0, %1, %2" : "=v"(r) : "v"(lo), "v"(hi)); return r; }
__device__ __forceinline__ bf16x8 pack8(f32x4 a, f32x4 b) { u32x4 w = {cvtpk(a[0], a[1]), cvtpk(a[2], a[3]), cvtpk(b[0], b[1]), cvtpk(b[2], b[3])}; return __builtin_bit_cast(bf16x8, w); }
__device__ __forceinline__ float bf_lo(unsigned w) { return __uint_as_float(w << 16); }
__device__ __forceinline__ float bf_hi(unsigned w) { return __uint_as_float(w & 0xffff0000u); }
__device__ __forceinline__ unsigned off_a(unsigned row, unsigned ch) { return 2048u * (row >> 3) + 512u * (ch >> 2) + 64u * (row & 7) + 16u * ((ch & 3) ^ ((row >> 2) & 3)); }
__device__ __forceinline__ unsigned rowb_of(int lane, int par) { const unsigned r = lane & 31, hi = lane >> 5; return 2048u * (r >> 3) + 64u * (r & 7) + 16u * ((2u * par + hi) ^ ((r >> 2) & 3)); }
__device__ __forceinline__ unsigned trb_of(int lane, int t) { const unsigned hi = lane >> 5, blk = (lane >> 4) & 1, q = (lane & 15) >> 2, p = lane & 3; return 2048u * hi + 64u * (4u * t + q) + 16u * ((2u * blk + (p >> 1)) ^ (2u * hi + t)) + 8u * (p & 1); }
template <int OFF> __device__ __forceinline__ s16x4 tr_read(unsigned a) { s16x4 r; asm volatile("ds_read_b64_tr_b16 %0, %1 offset:%2" : "=&v"(r) : "v"(a), "i"(OFF) : "memory"); return r; }
#define PK_LH(L, H) (bf16x8){L[0], L[1], L[2], L[3], H[0], H[1], H[2], H[3]}
#define PK4(P, BASE, OUT) do { unsigned a0_ = cvtpk(P[BASE + 0], P[BASE + 1]), a1_ = cvtpk(P[BASE + 2], P[BASE + 3]);   \
    unsigned b0_ = cvtpk(P[BASE + 4], P[BASE + 5]), b1_ = cvtpk(P[BASE + 6], P[BASE + 7]);                              \
    auto r0_ = __builtin_amdgcn_permlane32_swap(a0_, b0_, false, false); auto r1_ = __builtin_amdgcn_permlane32_swap(a1_, b1_, false, false); \
    u32x4 w_ = {r0_[0], r1_[0], r0_[1], r1_[1]}; OUT = __builtin_bit_cast(bf16x8, w_); } while (0)

__device__ __forceinline__ int t5_bucket(int rel) {
    const int base = rel > 0 ? 16 : 0, n = rel < 0 ? -rel : rel;
    int b;
    if (n < 8) b = n; else if (n < 12) b = 8; else if (n < 16) b = 9; else if (n < 23) b = 10; else if (n < 32) b = 11; else if (n < 46) b = 12; else if (n < 64) b = 13; else if (n < 91) b = 14; else b = 15;
    return base + b;
}

constexpr int AT_KV = 0;
constexpr int AT_X1 = 0;
constexpr int AT_Y = 65536;
constexpr int AT_BIAS = 133120;
constexpr int AT_WS = 134400;
constexpr int AT_END = 136448;

struct AttnP {
    const bf16_t* DQ; const bf16_t* DK; const bf16_t* DV;
    const float* ck; const float* cv;
    const float* nk; const float* nv;
    bf16_t* DO;
    float* part;
    const float* relb;
    const float* subln;
    float lam, omli;
};

__device__ __forceinline__ void attn_finalize(LAS unsigned char* lds, const f32x16 (&on)[4], bool act, int comp, int slot, size_t tok0, int h, const AttnP& P, int lane) {
    const int r32 = lane & 31, hi = lane >> 5;
    LAS float* X1 = (LAS float*)(lds + AT_X1) + slot * 4096;
    LAS float* Y = (LAS float*)(lds + AT_Y) + slot * (32 * 132);
    __syncthreads();
    if (act && comp == 1) {
#pragma unroll
        for (int d0 = 0; d0 < 4; ++d0)
#pragma unroll
            for (int r = 0; r < 16; ++r) X1[(d0 * 16 + r) * 64 + lane] = on[d0][r];
    }
    __syncthreads();
    if (act && comp == 0) {
#pragma unroll
        for (int d0 = 0; d0 < 4; ++d0)
#pragma unroll
            for (int r = 0; r < 16; ++r) Y[crow(r, hi) * 132 + d0 * 32 + r32] = on[d0][r] - P.lam * X1[(d0 * 16 + r) * 64 + lane];
        asm volatile("s_waitcnt lgkmcnt(0)" ::: "memory");
        f32x4 v[16]; float sq = 0.f;
#pragma unroll
        for (int j = 0; j < 16; ++j) { v[j] = *(const LAS f32x4*)(Y + r32 * 132 + 64 * hi + 4 * j); sq += (v[j][0] * v[j][0] + v[j][1] * v[j][1]) + (v[j][2] * v[j][2] + v[j][3] * v[j][3]); }
        { auto rr = __builtin_amdgcn_permlane32_swap(__float_as_uint(sq), __float_as_uint(sq), false, false); sq = __uint_as_float(rr[0]) + __uint_as_float(rr[1]); }
        const float rinv = rsqrtf(sq * (1.0f / 128.0f) + 1e-6f) * P.omli;
        bf16_t* orow = P.DO + (tok0 + r32) * 1024 + h * 128 + 64 * hi;
#pragma unroll
        for (int j = 0; j < 8; ++j) { const f32x4 g0 = *(const f32x4*)(P.subln + 64 * hi + 8 * j), g1 = *(const f32x4*)(P.subln + 64 * hi + 8 * j + 4);
            *(u32x4*)(orow + 8 * j) = __builtin_bit_cast(u32x4, pack8(v[2 * j] * rinv * g0, v[2 * j + 1] * rinv * g1)); }
    }
}

template <bool SAMPLE>
__device__ __forceinline__ void attn_unit(LAS unsigned char* lds, const AttnP& P, int b, int h, int x  ) {
    int tid_o = threadIdx.x; asm volatile("" : "+v"(tid_o)); const int tid = tid_o, lane = tid & 63, r32 = lane & 31, hi = lane >> 5; const int wid = __builtin_amdgcn_readfirstlane(tid >> 6);
    const int qt = SAMPLE ? ((wid >> 1) & 1) : (wid >> 1), comp = wid & 1;
    const bool wact = SAMPLE ? (wid < 4) : true;
    const int NT = SAMPLE ? (x == 3 ? 17 : 16) : (2 * x + 2);
    const int t0 = SAMPLE ? 16 * x : 0;
    const int nt_w = SAMPLE ? NT : (qt >= 2 ? NT : NT - 1);
    const int q0w = SAMPLE ? (PAST + 32 * qt) : (128 * x + 32 * qt);
    const size_t qtok = SAMPLE ? (size_t)(T_P + b * 64 + 32 * qt) : (size_t)(b * 2048 + 128 * x + 32 * qt);
    LAS float* btab = (LAS float*)(lds + AT_BIAS);
    LAS float* wsf = (LAS float*)(lds + AT_WS) + wid * 64;
    __syncthreads();
    if (tid < 320) btab[tid] = P.relb[t5_bucket(tid - 255) * 8 + h] * LOG2E;
    const float cfar = P.relb[15 * 8 + h] * LOG2E;
    bf16x8 qr[4];
#pragma unroll
    for (int d0 = 0; d0 < 4; ++d0) qr[d0] = *(const bf16x8*)(P.DQ + (qtok + r32) * 1024 + h * 128 + 64 * comp + 16 * d0 + 8 * hi);
    const int sr = tid >> 4, ch = tid & 15;
    const unsigned st0 = off_a(sr, ch), st1 = off_a(sr + 32, ch);
    const unsigned rb0 = rowb_of(lane, 0), rb1 = rowb_of(lane, 1), tb0 = trb_of(lane, 0), tb1 = trb_of(lane, 1);
    const unsigned ldsb = (unsigned)(uintptr_t)lds;
    bf16x8 sk0, sk1, sv0, sv1;
    f32x4 fk[4], fv[4];
#define AT_LOAD(t) do { if (SAMPLE) { const int tt_ = t0 + (t); const size_t ro_ = (tt_ < 64 ? ((size_t)b * PAST + 64 * tt_ + sr) : ((size_t)b * 64 + sr)) * 1024 + h * 128 + 8 * ch; \
        const float* a0_ = (tt_ < 64 ? P.ck : P.nk) + ro_; const float* c0_ = (tt_ < 64 ? P.cv : P.nv) + ro_; const float* a1_ = a0_ + 32 * 1024; const float* c1_ = c0_ + 32 * 1024; \
        fk[0] = *(const f32x4*)a0_; fk[1] = *(const f32x4*)(a0_ + 4); fk[2] = *(const f32x4*)a1_; fk[3] = *(const f32x4*)(a1_ + 4); fv[0] = *(const f32x4*)c0_; fv[1] = *(const f32x4*)(c0_ + 4); fv[2] = *(const f32x4*)c1_; fv[3] = *(const f32x4*)(c1_ + 4); } \
      else { const size_t ro_ = ((size_t)b * 2048 + 64 * (t) + sr) * 1024 + h * 128 + 8 * ch; \
        sk0 = *(const bf16x8*)(P.DK + ro_); sk1 = *(const bf16x8*)(P.DK + ro_ + 32 * 1024); sv0 = *(const bf16x8*)(P.DV + ro_); sv1 = *(const bf16x8*)(P.DV + ro_ + 32 * 1024); } } while (0)
#define AT_WRITE(buf) do { LAS unsigned char* kb_ = lds + AT_KV + (buf) * 32768; if (SAMPLE) { sk0 = pack8(fk[0], fk[1]); sk1 = pack8(fk[2], fk[3]); sv0 = pack8(fv[0], fv[1]); sv1 = pack8(fv[2], fv[3]); } \
        *(LAS bf16x8*)(kb_ + st0) = sk0; *(LAS bf16x8*)(kb_ + st1) = sk1; *(LAS bf16x8*)(kb_ + 16384 + st0) = sv0; *(LAS bf16x8*)(kb_ + 16384 + st1) = sv1; } while (0)
    float m_reg = -1e30f, l_reg = 0.f; f32x16 o[4];
#pragma unroll
    for (int d0 = 0; d0 < 4; ++d0) o[d0] = (f32x16){};
    AT_LOAD(0); AT_WRITE(0);
    if (NT > 1) AT_LOAD(1);
    __syncthreads();
    for (int j = 0; j < NT; ++j) {
        const int buf = j & 1;
        if (wact && j < nt_w) {
            LAS unsigned char* Kt = lds + AT_KV + buf * 32768; const unsigned Vt = ldsb + AT_KV + buf * 32768 + 16384;
            const int k0 = SAMPLE ? ((t0 + j) < 64 ? 64 * (t0 + j) : PAST) : 64 * j;
            f32x16 p0, p1;
            if (k0 + 63 - q0w <= -91) {
#pragma unroll
                for (int r = 0; r < 16; ++r) { p0[r] = cfar; p1[r] = cfar; }
            } else {
                const int ib = k0 - q0w - r32 + 4 * hi + 255;
#pragma unroll
                for (int r = 0; r < 16; ++r) { p0[r] = btab[ib + (r & 3) + 8 * (r >> 2)]; p1[r] = btab[ib + 32 + (r & 3) + 8 * (r >> 2)]; }
            }
#pragma unroll
            for (int d0 = 0; d0 < 4; ++d0) { const int s = 4 * comp + d0; const unsigned ro = ((s & 1) ? rb1 : rb0) + 512u * (s >> 1);
                const bf16x8 k0f = *(const LAS bf16x8*)(Kt + ro), k1f = *(const LAS bf16x8*)(Kt + 8192 + ro);
                p0 = __builtin_amdgcn_mfma_f32_32x32x16_bf16(k0f, qr[d0], p0, 0, 0, 0);
                p1 = __builtin_amdgcn_mfma_f32_32x32x16_bf16(k1f, qr[d0], p1, 0, 0, 0); }
            float pmax = p0[0];
#pragma unroll
            for (int r = 1; r < 16; ++r) pmax = fmaxf(pmax, p0[r]);
#pragma unroll
            for (int r = 0; r < 16; ++r) pmax = fmaxf(pmax, p1[r]);
            { auto rr = __builtin_amdgcn_permlane32_swap(__float_as_uint(pmax), __float_as_uint(pmax), false, false); pmax = fmaxf(__uint_as_float(rr[0]), __uint_as_float(rr[1])); }
            float alpha = 1.f;
            if (!__all(pmax - m_reg <= 8.0f)) { const float mn = fmaxf(m_reg, pmax); alpha = __builtin_amdgcn_exp2f(m_reg - mn); m_reg = mn;
                if (hi == 0) wsf[r32] = alpha; asm volatile("s_waitcnt lgkmcnt(0)" ::: "memory");
#pragma unroll
                for (int d0 = 0; d0 < 4; ++d0)
#pragma unroll
                    for (int r = 0; r < 16; ++r) o[d0][r] *= wsf[crow(r, hi)];
            }
            float ps = 0.f;
#pragma unroll
            for (int r = 0; r < 16; ++r) { p0[r] = __builtin_amdgcn_exp2f(p0[r] - m_reg); p1[r] = __builtin_amdgcn_exp2f(p1[r] - m_reg); ps += p0[r] + p1[r]; }
            { auto rr = __builtin_amdgcn_permlane32_swap(__float_as_uint(ps), __float_as_uint(ps), false, false); ps = __uint_as_float(rr[0]) + __uint_as_float(rr[1]); }
            l_reg = l_reg * alpha + ps;
            bf16x8 pa0, pa1, pa2, pa3;
            PK4(p0, 0, pa0); PK4(p0, 8, pa1); PK4(p1, 0, pa2); PK4(p1, 8, pa3);
#define AT_PV(D0) do { const s16x4 l0_ = tr_read<(D0) * 512>(Vt + tb0), h0_ = tr_read<(D0) * 512>(Vt + tb1), l1_ = tr_read<(D0) * 512 + 4096>(Vt + tb0), h1_ = tr_read<(D0) * 512 + 4096>(Vt + tb1); \
                const s16x4 l2_ = tr_read<(D0) * 512 + 8192>(Vt + tb0), h2_ = tr_read<(D0) * 512 + 8192>(Vt + tb1), l3_ = tr_read<(D0) * 512 + 12288>(Vt + tb0), h3_ = tr_read<(D0) * 512 + 12288>(Vt + tb1); \
                asm volatile("s_waitcnt lgkmcnt(0)" ::: "memory"); SBAR(); \
                o[D0] = __builtin_amdgcn_mfma_f32_32x32x16_bf16(pa0, PK_LH(l0_, h0_), o[D0], 0, 0, 0); o[D0] = __builtin_amdgcn_mfma_f32_32x32x16_bf16(pa1, PK_LH(l1_, h1_), o[D0], 0, 0, 0); \
                o[D0] = __builtin_amdgcn_mfma_f32_32x32x16_bf16(pa2, PK_LH(l2_, h2_), o[D0], 0, 0, 0); o[D0] = __builtin_amdgcn_mfma_f32_32x32x16_bf16(pa3, PK_LH(l3_, h3_), o[D0], 0, 0, 0); } while (0)
            AT_PV(0); AT_PV(1); AT_PV(2); AT_PV(3);
        }
        if (j + 1 < NT) { AT_WRITE(buf ^ 1); }
        if (j + 2 < NT) { AT_LOAD(j + 2); }
        __syncthreads();
    }
    if (SAMPLE) {
        if (wact) {
            float* rec = P.part + ((size_t)((b * 8 + h) * 4 + x) * 4 + wid) * 4224;
#pragma unroll
            for (int d0 = 0; d0 < 4; ++d0)
#pragma unroll
                for (int r = 0; r < 16; ++r) rec[(d0 * 16 + r) * 64 + lane] = o[d0][r];
            if (hi == 0) { rec[4096 + r32] = m_reg; rec[4128 + r32] = l_reg; }
        }
    } else {
        if (hi == 0) wsf[r32] = l_reg; asm volatile("s_waitcnt lgkmcnt(0)" ::: "memory");
#pragma unroll
        for (int r = 0; r < 16; ++r) { const float il = __builtin_amdgcn_rcpf(wsf[crow(r, hi)]);
#pragma unroll
            for (int d0 = 0; d0 < 4; ++d0) o[d0][r] *= il; }
        attn_finalize(lds, o, true, comp, qt, qtok, h, P, lane);
    }
#undef AT_LOAD
#undef AT_WRITE
#undef AT_PV
}

__device__ __forceinline__ void attn_merge_unit(LAS unsigned char* lds, const AttnP& P, int b, int h) {
    int tid_o = threadIdx.x; asm volatile("" : "+v"(tid_o)); const int tid = tid_o, lane = tid & 63, r32 = lane & 31, hi = lane >> 5; const int wid = __builtin_amdgcn_readfirstlane(tid >> 6);
    const bool wact = wid < 4; const int qt = (wid >> 1) & 1, comp = wid & 1;
    LAS float* wsf = (LAS float*)(lds + AT_WS) + wid * 64;
    LAS float* sc = (LAS float*)(lds + AT_WS) + (wid & 3) * 128;
    f32x16 on[4];
#pragma unroll
    for (int d0 = 0; d0 < 4; ++d0) on[d0] = (f32x16){};
    __syncthreads();
    if (wact) {
        const float* rec = P.part + ((size_t)((b * 8 + h) * 4) * 4 + wid) * 4224;
        float ms[4], ls[4]; float M = -1e30f;
#pragma unroll
        for (int s = 0; s < 4; ++s) { ms[s] = rec[(size_t)s * 16896 + 4096 + r32]; ls[s] = rec[(size_t)s * 16896 + 4128 + r32]; M = fmaxf(M, ms[s]); }
        float L = 0.f;
#pragma unroll
        for (int s = 0; s < 4; ++s) { ms[s] = __builtin_amdgcn_exp2f(ms[s] - M); L += ls[s] * ms[s]; }
        const float iL = 1.0f / L;
        if (hi == 0) {
#pragma unroll
            for (int s = 0; s < 4; ++s) sc[s * 32 + r32] = ms[s] * iL; }
        asm volatile("s_waitcnt lgkmcnt(0)" ::: "memory");
#pragma unroll
        for (int s = 0; s < 4; ++s) {
#pragma unroll
            for (int r = 0; r < 16; ++r) { const float w = sc[s * 32 + crow(r, hi)];
#pragma unroll
                for (int d0 = 0; d0 < 4; ++d0) on[d0][r] += w * rec[(size_t)s * 16896 + (d0 * 16 + r) * 64 + lane]; } }
    }
    (void)wsf;
    attn_finalize(lds, on, wact, comp, qt, (size_t)(T_P + b * 64 + 32 * qt), h, P, lane);
}

constexpr int RT_Q = 0, RT_K = 16384, RT_V = 32768, RT_KW = 49152, RT_OUT = 65536;
constexpr int RT_END = RT_OUT + 64 * 132 * 4;
struct RetP {
    const bf16_t* RQ; const bf16_t* RK; const bf16_t* RV; const bf16_t* RG;
    bf16_t* RO;
    const float* s0;
    float* sP; float* sS;
};
__device__ __forceinline__ void ret_unit(LAS unsigned char* lds, const RetP& P, bool sample, int b, int h) {
    int tid_o = threadIdx.x; asm volatile("" : "+v"(tid_o)); const int tid = tid_o, lane = tid & 63, r32 = lane & 31, hi = lane >> 5; const int wid = __builtin_amdgcn_readfirstlane(tid >> 6);
    const int et = wid & 3, ih = wid >> 2;
    const int nch = sample ? 1 : 32;
    const size_t tok0 = sample ? (size_t)(T_P + b * 64) : (size_t)b * 2048;
    const float lg2 = log1pf(-__builtin_amdgcn_exp2f((float)(-5 - h))) * LOG2E;
    const float dec = __builtin_amdgcn_exp2f(lg2 * 64.0f);
    const int sr = tid >> 4, ch = tid & 15;
    const unsigned st0 = off_a(sr, ch), st1 = off_a(sr + 32, ch);
    const float we0 = __builtin_amdgcn_exp2f(lg2 * (float)(63 - sr)), we1 = __builtin_amdgcn_exp2f(lg2 * (float)(31 - sr));
    const unsigned rb0 = rowb_of(lane, 0), rb1 = rowb_of(lane, 1), tb0 = trb_of(lane, 0), tb1 = trb_of(lane, 1);
    const unsigned ldsb = (unsigned)(uintptr_t)lds;
    LAS float* OUT = (LAS float*)(lds + RT_OUT);
    f32x16 S[4];
    if (sample) { const float* s = P.s0 + ((size_t)(b * 8 + h) * 128) * 128 + 32 * et + r32;
#pragma unroll
        for (int dt = 0; dt < 4; ++dt)
#pragma unroll
            for (int r = 0; r < 16; ++r) S[dt][r] = s[(size_t)(32 * dt + crow(r, hi)) * 128]; }
    else {
#pragma unroll
        for (int dt = 0; dt < 4; ++dt) S[dt] = (f32x16){}; }
    const float dmb = (float)(32 * ih + r32 - 4 * hi);
    unsigned qpb[4];
#pragma unroll
    for (int q = 0; q < 4; ++q) { const unsigned row = 32 * ih + r32; qpb[q] = 2048u * (row >> 3) + 64u * (row & 7) + 16u * ((unsigned)q ^ ((row >> 2) & 3)) + 8u * hi; }
    bf16x8 gq0, gq1, gk0, gk1, gv0, gv1;
#define RT_LOAD(c) do { const size_t t_ = tok0 + 64 * (c); const size_t o0_ = (t_ + sr) * 1024 + h * 128 + 8 * ch, o1_ = (t_ + sr + 32) * 1024 + h * 128 + 8 * ch; \
        gq0 = *(const bf16x8*)(P.RQ + o0_); gq1 = *(const bf16x8*)(P.RQ + o1_); gk0 = *(const bf16x8*)(P.RK + o0_); gk1 = *(const bf16x8*)(P.RK + o1_); gv0 = *(const bf16x8*)(P.RV + o0_); gv1 = *(const bf16x8*)(P.RV + o1_); } while (0)
    RT_LOAD(0);
    __syncthreads();
    for (int c = 0; c < nch; ++c) {
        float lgc = lg2; asm volatile("" : "+v"(lgc));
        { *(LAS bf16x8*)(lds + RT_Q + st0) = gq0; *(LAS bf16x8*)(lds + RT_Q + st1) = gq1; *(LAS bf16x8*)(lds + RT_K + st0) = gk0; *(LAS bf16x8*)(lds + RT_K + st1) = gk1;
          *(LAS bf16x8*)(lds + RT_V + st0) = gv0; *(LAS bf16x8*)(lds + RT_V + st1) = gv1;
          const u32x4 a = __builtin_bit_cast(u32x4, gk0), bq = __builtin_bit_cast(u32x4, gk1); u32x4 wa, wb;
#pragma unroll
          for (int q = 0; q < 4; ++q) { wa[q] = cvtpk(bf_lo(a[q]) * we0, bf_hi(a[q]) * we0); wb[q] = cvtpk(bf_lo(bq[q]) * we1, bf_hi(bq[q]) * we1); }
          *(LAS u32x4*)(lds + RT_KW + st0) = wa; *(LAS u32x4*)(lds + RT_KW + st1) = wb; }
        __syncthreads();
        if (c + 1 < nch) RT_LOAD(c + 1);
        f32x16 p0 = (f32x16){}, p1 = (f32x16){};
#pragma unroll
        for (int s = 0; s < 8; ++s) { const unsigned ro = ((s & 1) ? rb1 : rb0) + 512u * (s >> 1);
            const bf16x8 k0f = *(const LAS bf16x8*)(lds + RT_K + ro), k1f = *(const LAS bf16x8*)(lds + RT_K + 8192 + ro), qf = *(const LAS bf16x8*)(lds + RT_Q + 8192 * ih + ro);
            p0 = __builtin_amdgcn_mfma_f32_32x32x16_bf16(k0f, qf, p0, 0, 0, 0); p1 = __builtin_amdgcn_mfma_f32_32x32x16_bf16(k1f, qf, p1, 0, 0, 0); }
#pragma unroll
        for (int r = 0; r < 16; ++r) { const float dj = dmb - (float)((r & 3) + 8 * (r >> 2));
            p0[r] *= __builtin_amdgcn_exp2f(lgc * __builtin_fabsf(dj)); p1[r] *= __builtin_amdgcn_exp2f(lgc * __builtin_fabsf(dj - 32.0f)); }
        bf16x8 pa0, pa1, pa2, pa3;
        PK4(p0, 0, pa0); PK4(p0, 8, pa1); PK4(p1, 0, pa2); PK4(p1, 8, pa3);
        bf16x8 vf[4];
        { const unsigned Vt = ldsb + RT_V + 512u * et;
          const s16x4 l0_ = tr_read<0>(Vt + tb0), h0_ = tr_read<0>(Vt + tb1), l1_ = tr_read<4096>(Vt + tb0), h1_ = tr_read<4096>(Vt + tb1);
          const s16x4 l2_ = tr_read<8192>(Vt + tb0), h2_ = tr_read<8192>(Vt + tb1), l3_ = tr_read<12288>(Vt + tb0), h3_ = tr_read<12288>(Vt + tb1);
          asm volatile("s_waitcnt lgkmcnt(0)" ::: "memory"); SBAR();
          vf[0] = PK_LH(l0_, h0_); vf[1] = PK_LH(l1_, h1_); vf[2] = PK_LH(l2_, h2_); vf[3] = PK_LH(l3_, h3_); }
        f32x16 oi = (f32x16){}, oe = (f32x16){};
        oi = __builtin_amdgcn_mfma_f32_32x32x16_bf16(pa0, vf[0], oi, 0, 0, 0); oi = __builtin_amdgcn_mfma_f32_32x32x16_bf16(pa1, vf[1], oi, 0, 0, 0);
        oi = __builtin_amdgcn_mfma_f32_32x32x16_bf16(pa2, vf[2], oi, 0, 0, 0); oi = __builtin_amdgcn_mfma_f32_32x32x16_bf16(pa3, vf[3], oi, 0, 0, 0);
#pragma unroll
        for (int dt = 0; dt < 4; ++dt)
#pragma unroll
            for (int s = 0; s < 2; ++s) {
                const s16x4 qa = *(const LAS s16x4*)(lds + RT_Q + qpb[2 * s] + 512 * dt), qb = *(const LAS s16x4*)(lds + RT_Q + qpb[2 * s + 1] + 512 * dt);
                u32x4 sw; sw[0] = cvtpk(S[dt][8 * s + 0], S[dt][8 * s + 1]); sw[1] = cvtpk(S[dt][8 * s + 2], S[dt][8 * s + 3]); sw[2] = cvtpk(S[dt][8 * s + 4], S[dt][8 * s + 5]); sw[3] = cvtpk(S[dt][8 * s + 6], S[dt][8 * s + 7]);
                oe = __builtin_amdgcn_mfma_f32_32x32x16_bf16(PK_LH(qa, qb), __builtin_bit_cast(bf16x8, sw), oe, 0, 0, 0); }
#pragma unroll
        for (int r = 0; r < 16; ++r) OUT[(32 * ih + crow(r, hi)) * 132 + 32 * et + r32] = oi[r] + __builtin_amdgcn_exp2f(lgc * (float)(32 * ih + crow(r, hi) + 1)) * oe[r];
#pragma unroll
        for (int dt = 0; dt < 4; ++dt) {
            const unsigned Kw = ldsb + RT_KW + 512u * dt;
            const s16x4 l0_ = tr_read<0>(Kw + tb0), h0_ = tr_read<0>(Kw + tb1), l1_ = tr_read<4096>(Kw + tb0), h1_ = tr_read<4096>(Kw + tb1);
            const s16x4 l2_ = tr_read<8192>(Kw + tb0), h2_ = tr_read<8192>(Kw + tb1), l3_ = tr_read<12288>(Kw + tb0), h3_ = tr_read<12288>(Kw + tb1);
            asm volatile("s_waitcnt lgkmcnt(0)" ::: "memory"); SBAR();
#pragma unroll
            for (int r = 0; r < 16; ++r) S[dt][r] *= dec;
            S[dt] = __builtin_amdgcn_mfma_f32_32x32x16_bf16(PK_LH(l0_, h0_), vf[0], S[dt], 0, 0, 0); S[dt] = __builtin_amdgcn_mfma_f32_32x32x16_bf16(PK_LH(l1_, h1_), vf[1], S[dt], 0, 0, 0);
            S[dt] = __builtin_amdgcn_mfma_f32_32x32x16_bf16(PK_LH(l2_, h2_), vf[2], S[dt], 0, 0, 0); S[dt] = __builtin_amdgcn_mfma_f32_32x32x16_bf16(PK_LH(l3_, h3_), vf[3], S[dt], 0, 0, 0); }
        __syncthreads();
        { const int row = tid >> 3, sg = tid & 7; f32x4 v[4]; float sq = 0.f;
#pragma unroll
          for (int q = 0; q < 4; ++q) { v[q] = *(const LAS f32x4*)(OUT + row * 132 + 16 * sg + 4 * q); sq += (v[q][0] * v[q][0] + v[q][1] * v[q][1]) + (v[q][2] * v[q][2] + v[q][3] * v[q][3]); }
          sq += __shfl_xor(sq, 1); sq += __shfl_xor(sq, 2); sq += __shfl_xor(sq, 4);
          const float rinv = rsqrtf(sq * (1.0f / 128.0f) + 1e-6f);
          const size_t go = (tok0 + 64 * c + row) * 1024 + h * 128 + 16 * sg;
          const u32x4 g0 = *(const u32x4*)(P.RG + go), g1 = *(const u32x4*)(P.RG + go + 8);
          f32x4 ga, gb, gc, gd;
          ga = (f32x4){bf_lo(g0[0]), bf_hi(g0[0]), bf_lo(g0[1]), bf_hi(g0[1])}; gb = (f32x4){bf_lo(g0[2]), bf_hi(g0[2]), bf_lo(g0[3]), bf_hi(g0[3])};
          gc = (f32x4){bf_lo(g1[0]), bf_hi(g1[0]), bf_lo(g1[1]), bf_hi(g1[1])}; gd = (f32x4){bf_lo(g1[2]), bf_hi(g1[2]), bf_lo(g1[3]), bf_hi(g1[3])};
          *(u32x4*)(P.RO + go) = __builtin_bit_cast(u32x4, pack8(v[0] * rinv * ga, v[1] * rinv * gb));
          *(u32x4*)(P.RO + go + 8) = __builtin_bit_cast(u32x4, pack8(v[2] * rinv * gc, v[3] * rinv * gd)); }
    }
    if (ih == 0) { float* so = (sample ? P.sS : P.sP) + ((size_t)(b * 8 + h) * 128) * 128 + 32 * et + r32;
#pragma unroll
        for (int dt = 0; dt < 4; ++dt)
#pragma unroll
            for (int r = 0; r < 16; ++r) so[(size_t)(32 * dt + crow(r, hi)) * 128] = S[dt][r]; }
#undef RT_LOAD
}
#undef LAS
}

#ifndef MK_PER_PHASE
#define MK_PER_PHASE 0
#endif
#ifndef PROBE_DUP
#define PROBE_DUP 0
#endif
constexpr int NWAVES = 8;
constexpr int NPHASE = 1 + 9 * DEPTH;
constexpr size_t MiB = 1u << 20;
constexpr size_t WS_CTL = 0, CTL_ZERO_BYTES = 1 * MiB;
constexpr size_t WS_ROT = 1 * MiB;
constexpr size_t WS_LAM = 3 * MiB;
constexpr size_t WS_W = 4 * MiB;
constexpr size_t O_WGU1 = 0, O_WD1 = 23068672, O_WIN = 34603008, O_WR = 57671680, O_WDU = 59768832, O_WO = 61865984, O_WGU2 = 66060288, O_WD2 = 89128960, LAYER_W = 100663296;
constexpr size_t WS_XB = 388 * MiB, WS_HID = 454 * MiB;
constexpr size_t WS_RQ = 636 * MiB, WS_RK = 669 * MiB, WS_RV = 702 * MiB, WS_RG = 735 * MiB, WS_DQ = 768 * MiB, WS_DK = 801 * MiB, WS_DV = 834 * MiB;
constexpr size_t WS_GR = 867 * MiB, WS_GD = 933 * MiB, WS_RO = 999 * MiB, WS_DO = 1032 * MiB, WS_MRG = 1065 * MiB, WS_PART = 1131 * MiB, WS_END = 1148 * MiB;
static_assert(WS_W + 2 * LAYER_W * 2 <= WS_XB && WS_XB + (size_t)TT * 2048 * 2 <= WS_HID && WS_HID + (size_t)TT * 5632 * 2 <= WS_RQ && WS_RQ + (size_t)TT * 1024 * 2 <= WS_RK, "ws map");
static_assert(WS_PART + (size_t)64 * 4 * 4 * 4224 * 4 <= WS_END, "ws map");
constexpr int CW_TMO = 0, CW_BAR = 4096, CW_SS = 16384;
static_assert((CW_SS + 7 * TT) * 4 <= (int)CTL_ZERO_BYTES, "ctl");
constexpr size_t OUT_Y = 0, OUT_KP = 34603008, OUT_VP = 68157440, OUT_RP = 101711872, OUT_KS = 103809024, OUT_VS = 104857600, OUT_RS = 105906176, OUT_END = 108003328;
constexpr int LDS_BYTES = 163840, MISC_OFF = LDS_BYTES - 256;
static_assert(mix::AT_END <= MISC_OFF && mix::RT_END <= MISC_OFF && pg8::STAGE_BYTES <= MISC_OFF, "lds map");

#define GAS __attribute__((address_space(1)))
#define LAS __attribute__((address_space(3)))
typedef unsigned short bf16;
typedef unsigned v4u __attribute__((ext_vector_type(4)));
typedef float f32x4 __attribute__((ext_vector_type(4)));
__device__ __forceinline__ unsigned f2bf(float f) { unsigned u = __builtin_bit_cast(unsigned, f); return (u + 0x7fffu + ((u >> 16) & 1u)) >> 16; }
__device__ __forceinline__ unsigned pk2(float lo, float hi) { return f2bf(lo) | (f2bf(hi) << 16); }
__device__ __forceinline__ float wave_sum(float v) {
#pragma unroll
    for (int o = 1; o < 64; o <<= 1) v += __shfl_xor(v, o);
    return v;
}

#define XB_TMO      128
#define XB_XCNT(j)  (256  + 64 * (j))
#define XB_XSUB(j)  (1280 + 64 * (j))
#define XB_XGEN(j)  (2304 + 64 * (j))
#define XB_TOP      3328
#define XB_TOPGEN   3392
#define XCD_BAR_WORDS 3456
#define XB_SPIN_CAP (1u << 18)

__device__ __forceinline__ unsigned xb_ld(unsigned* p)              { return __hip_atomic_load(p, __ATOMIC_RELAXED, __HIP_MEMORY_SCOPE_AGENT); }
__device__ __forceinline__ unsigned xb_add(unsigned* p, unsigned v) { return __hip_atomic_fetch_add(p, v, __ATOMIC_RELAXED, __HIP_MEMORY_SCOPE_AGENT); }
__device__ __forceinline__ unsigned xb_xcc_id() { return (unsigned)__builtin_amdgcn_s_getreg((3 << 11) | 20) & 0xFu; }
#define XB_SPIN(cond, bar) do { unsigned _sp = 0; while (cond) { __builtin_amdgcn_s_sleep(1); \
    if ((++_sp & 255u) == 0u) { if (xb_ld(&(bar)[XB_TMO])) break; if (_sp > XB_SPIN_CAP) { atomicAdd(&(bar)[XB_TMO], 1u); break; } } } } while (0)

struct XcdBarrier {
    unsigned* bar; unsigned x;
    volatile LAS unsigned* st;
};

__device__ __forceinline__ XcdBarrier xcd_barrier_post(unsigned* bar, volatile LAS unsigned* st) {
    XcdBarrier b; b.bar = bar; b.x = xb_xcc_id(); b.st = st;
    if (threadIdx.x == 0) (void)xb_add(&bar[XB_XCNT(b.x)], 1u);
    return b;
}
__device__ __forceinline__ void xcd_barrier_complete(unsigned* bar, unsigned x, unsigned& nloc, unsigned& nx) {
    const unsigned G = gridDim.x * gridDim.y * gridDim.z;
    unsigned sum, cnt, mine, sp = 0u;
    for (;;) {
        sum = 0u; cnt = 0u; mine = 0u;
#pragma unroll
        for (unsigned j = 0; j < 16; ++j) { const unsigned c = xb_ld(&bar[XB_XCNT(j)]); sum += c; cnt += (c > 0u) ? 1u : 0u; mine = (j == x) ? c : mine; }
        if (sum == G) break;
        __builtin_amdgcn_s_sleep(1);
        if ((++sp & 255u) == 0u) { if (xb_ld(&bar[XB_TMO])) break; if (sp > XB_SPIN_CAP) { atomicAdd(&bar[XB_TMO], 1u); break; } }
    }
    nloc = mine > 0u ? mine : 1u; nx = cnt > 0u ? cnt : 1u;
}

__device__ __forceinline__ void xcd_barrier(const XcdBarrier& b) {
    asm volatile("s_waitcnt vmcnt(0)" ::: "memory");
    __syncthreads();
    if (threadIdx.x == 0) {
        unsigned* bar = b.bar;
        __builtin_amdgcn_s_waitcnt(0);
        unsigned nloc = b.st[0], nx = b.st[1];
        if (nloc == 0u) { xcd_barrier_complete(bar, b.x, nloc, nx); b.st[0] = nloc; b.st[1] = nx; }
        const unsigned old = xb_add(&bar[XB_XSUB(b.x)], 1u);
        const unsigned gen = old / nloc;
        if (old + 1u == (gen + 1u) * nloc) {
            __builtin_amdgcn_fence(__ATOMIC_RELEASE, "agent");
            asm volatile("s_waitcnt vmcnt(0)" ::: "memory");
            const unsigned og = xb_add(&bar[XB_TOP], 1u);
            const unsigned tg = og / nx;
            if (og + 1u == (tg + 1u) * nx) xb_add(&bar[XB_TOPGEN], 1u);
            else XB_SPIN(xb_ld(&bar[XB_TOPGEN]) == tg, bar);
            __builtin_amdgcn_fence(__ATOMIC_ACQUIRE, "agent");
            xb_add(&bar[XB_XGEN(b.x)], 1u);
            asm volatile("s_waitcnt vmcnt(0)" ::: "memory");
        } else {
            XB_SPIN(xb_ld(&bar[XB_XGEN(b.x)]) == gen, bar);
            __builtin_amdgcn_fence(__ATOMIC_ACQUIRE, "agent");
            asm volatile("s_waitcnt vmcnt(0)" ::: "memory");
        }
    }
    __syncthreads();
}


struct Args { const float* in[26]; float* out; unsigned char* ws; int ph_lo, ph_hi; };

__device__ __forceinline__ void p0_item(const float* src, int ld, int k0, int col4, const float* gain, bf16* dst, int K, int p0, LAS float* scr, int lane) {
    f32x4 v[16];
#pragma unroll
    for (int i = 0; i < 16; ++i) v[i] = *(const f32x4*)(src + (size_t)(k0 + 4 * i + (lane >> 4)) * ld + col4);
    if (gain) {
#pragma unroll
        for (int i = 0; i < 16; ++i) v[i] = v[i] * gain[k0 + 4 * i + (lane >> 4)]; }
#pragma unroll
    for (int i = 0; i < 16; ++i) { LAS float* s = scr + (4 * i + (lane >> 4)) * 65 + 4 * (lane & 15); s[0] = v[i][0]; s[1] = v[i][1]; s[2] = v[i][2]; s[3] = v[i][3]; }
    asm volatile("s_waitcnt lgkmcnt(0)" ::: "memory");
    const int c = lane & 7;
#pragma unroll
    for (int j = 0; j < 8; ++j) { const int n = (lane >> 3) + 8 * j; const LAS float* s = scr + (8 * c) * 65 + n;
        v4u o; o.x = pk2(s[0 * 65], s[1 * 65]); o.y = pk2(s[2 * 65], s[3 * 65]); o.z = pk2(s[4 * 65], s[5 * 65]); o.w = pk2(s[6 * 65], s[7 * 65]);
        *(v4u*)(dst + (size_t)(p0 + n) * K + k0 + 8 * c) = o; }
    asm volatile("s_waitcnt lgkmcnt(0)" ::: "memory");
}

__device__ __forceinline__ void p0_prologue(const Args& a, LAS unsigned char* lds, int gw, int NGW, int lane, int wave) {
    LAS float* scr = (LAS float*)(lds + wave * 16896);
    bf16* W = (bf16*)(a.ws + WS_W);
    const int q4 = 4 * (lane & 15);
    for (int it = gw; it < 2 * 24576; it += NGW) {
        const int l = it / 24576; int r = it % 24576; bf16* Wl = W + (size_t)l * LAYER_W;
        if (r < 5632 || (r >= 16128 && r < 21760)) {
            const bool second = r >= 16128; if (second) r -= 16128;
            const int kb = r / 176, pb = r % 176, p0 = 64 * pb; const bool up = (p0 & 255) >= 128;
            const float* src = a.in[second ? (up ? 23 : 22) : (up ? 7 : 6)] + (size_t)l * 2048 * 5632;
            p0_item(src, 5632, 64 * kb, 128 * (p0 >> 8) + (p0 & 127) + q4, a.in[second ? 21 : 5] + l * 2048, Wl + (second ? O_WGU2 : O_WGU1), 2048, p0, scr, lane);
        } else if ((r >= 5632 && r < 8448) || r >= 21760) {
            const bool second = r >= 21760; r -= second ? 21760 : 5632;
            const int kb = r / 32, pb = r % 32;
            p0_item(a.in[second ? 24 : 8] + (size_t)l * 5632 * 2048, 2048, 64 * kb, 64 * pb + q4, nullptr, Wl + (second ? O_WD2 : O_WD1), 5632, 64 * pb, scr, lane);
        } else if (r < 14080) {
            r -= 8448; const int kb = r / 176, pb = r % 176, p0 = 64 * pb, seg = p0 >> 10, p = p0 + q4; int col;
            if (seg <= 1) { const int pl = p & 127; col = (p & ~127) + 16 * (pl >> 5) + 4 * ((pl >> 3) & 3) + 64 * ((pl >> 2) & 1); }
            else if (seg == 4 || seg == 5) { const int pt = p & 255; col = (p & ~255) + 64 * ((pt >> 5) & 3) + 32 * (pt >> 7) + (pt & 31); }
            else col = p;
            p0_item(a.in[10] + (size_t)l * 2048 * 11264, 11264, 64 * kb, col, a.in[9] + l * 2048, Wl + O_WIN, 2048, p0, scr, lane);
        } else if (r < 15104) {
            const bool dif = r >= 14592; r -= dif ? 14592 : 14080; const int kb = r / 32, pb = r % 32;
            p0_item(a.in[dif ? 19 : 18] + (size_t)l * 1024 * 2048, 2048, 64 * kb, 64 * pb + q4, nullptr, Wl + (dif ? O_WDU : O_WR), 1024, 64 * pb, scr, lane);
        } else {
            r -= 15104; const int kb = r / 32, pb = r % 32;
            p0_item(a.in[20] + (size_t)l * 2048 * 2048, 2048, 64 * kb, 64 * pb + q4, nullptr, Wl + O_WO, 2048, 64 * pb, scr, lane);
        }
    }
    { bf16* XB = (bf16*)(a.ws + WS_XB); float* ss0 = (float*)(a.ws + WS_CTL) + CW_SS;
      for (int t = gw; t < TT; t += NGW) { const float* xr = t < T_P ? a.in[0] + (size_t)t * 2048 : a.in[1] + (size_t)(t - T_P) * 2048;
          f32x4 v[8]; float s = 0.f;
#pragma unroll
          for (int j = 0; j < 8; ++j) { v[j] = *((const f32x4*)xr + lane + 64 * j); s += (v[j][0] * v[j][0] + v[j][1] * v[j][1]) + (v[j][2] * v[j][2] + v[j][3] * v[j][3]); }
          s = wave_sum(s);
          unsigned long long* o8 = (unsigned long long*)(XB + (size_t)t * 2048) + lane;
#pragma unroll
          for (int j = 0; j < 8; ++j) o8[64 * j] = (unsigned long long)pk2(v[j][0], v[j][1]) | ((unsigned long long)pk2(v[j][2], v[j][3]) << 32);
          if (lane == 0) ss0[t] = s; } }
    { float* rot = (float*)(a.ws + WS_ROT);
      for (int idx = gw * 64 + lane; idx < 2112 * 64; idx += NGW * 64) { const int slot = idx >> 6, i = idx & 63; const double pos = (double)(slot < 2048 ? slot : slot + 2048);
          double inv = 1.0; for (int q = 0; q < i; ++q) inv *= 0.8659643233600653;
          const double ang = pos * inv; const double k = __builtin_rint(ang * 0.6366197723675814);
          double r = __builtin_fma(-k, 1.5707963267948966, ang); r = __builtin_fma(-k, 6.123233995736766e-17, r);
          const double r2 = r * r;
          const double sn = r * (1.0 + r2 * (-1.0 / 6 + r2 * (1.0 / 120 + r2 * (-1.0 / 5040 + r2 * (1.0 / 362880 + r2 * (-1.0 / 39916800 + r2 * (1.0 / 6227020800.0)))))));
          const double cs = 1.0 + r2 * (-0.5 + r2 * (1.0 / 24 + r2 * (-1.0 / 720 + r2 * (1.0 / 40320 + r2 * (-1.0 / 3628800 + r2 * (1.0 / 479001600.0 + r2 * (-1.0 / 87178291200.0)))))));
          const int q = (int)((long long)k & 3); double c, s;
          if (q == 0) { c = cs; s = sn; } else if (q == 1) { c = -sn; s = cs; } else if (q == 2) { c = -cs; s = -sn; } else { c = sn; s = -cs; }
          rot[(size_t)slot * 128 + i] = (float)c; rot[(size_t)slot * 128 + 64 + i] = (float)s; } }
    if (gw == 0) { float* lam = (float*)(a.ws + WS_LAM);
        for (int l = 0; l < DEPTH; ++l) { const float s1 = wave_sum(a.in[13][l * 64 + lane] * a.in[14][l * 64 + lane]), s2 = wave_sum(a.in[15][l * 64 + lane] * a.in[16][l * 64 + lane]);
            const float li0 = 0.8f - 0.6f * expf(-0.3f * (float)l);
            if (lane == 0) { lam[2 * l] = expf(s1) - expf(s2) + li0; lam[2 * l + 1] = 1.0f - li0; } } }
}

__global__ void __launch_bounds__(NWAVES * 64, 2) mk_fwd(Args args) {
    extern __shared__ __attribute__((aligned(16))) unsigned char lds_raw[];
    LAS unsigned char* lds = (LAS unsigned char*)lds_raw;
    volatile LAS unsigned* MISC = (volatile LAS unsigned*)(lds + MISC_OFF);
    const int tid = threadIdx.x, lane = tid & 63, wave = __builtin_amdgcn_readfirstlane(tid >> 6);
    const int G = gridDim.x, bx = blockIdx.x;
    unsigned* ctl = (unsigned*)(args.ws + WS_CTL);
    for (int u = tid; u < 64; u += NWAVES * 64) MISC[u] = 0u;
    __syncthreads();
    XcdBarrier bar; bar.bar = ctl + CW_BAR; bar.x = 0; bar.st = nullptr;
    if (!MK_PER_PHASE) bar = xcd_barrier_post(ctl + CW_BAR, MISC + 8);
    const int lo = args.ph_lo, hi = args.ph_hi;
#define IN(k) (lo <= (k) && (k) < hi)
#define SEAM(k) do { if (IN((k) + 1)) xcd_barrier(bar); } while (0)
#define OPQ() int G_ = gridDim.x, bx_ = blockIdx.x; asm volatile("" : "+s"(G_), "+s"(bx_))
#define WSB(off) ((bf16*)(args.ws + (off)))
#define SSP(i) ((float*)(args.ws + WS_CTL) + CW_SS + (size_t)(i) * TT)
#define YP (args.out + OUT_Y)
#define WL(off) (WSB(WS_W) + (size_t)l * LAYER_W + (off))
    if (IN(0)) { int tid_o = threadIdx.x; asm volatile("" : "+v"(tid_o)); const int w_ = __builtin_amdgcn_readfirstlane(tid_o >> 6); for (int rep = 0; rep < ((PROBE_DUP & 1) ? 2 : 1); ++rep) { p0_prologue(args, lds, bx * NWAVES + w_, G * NWAVES, tid_o & 63, w_); __syncthreads(); } SEAM(0); }

    for (int l = 0; l < DEPTH; ++l) {
        const int pb = 1 + 9 * l;
        if (IN(pb + 0)) { OPQ(); pg8::Gemm g{WSB(WS_XB), WL(O_WGU1), TT, NPROJ, 2048}; pg8::StaticOrder S; S.init(TT, NPROJ, G_, bx_);
            pg8::EpiSwiglu E{WSB(WS_HID), SSP(3 * l)}; pg8::gemm_phase<pg8::EpiSwiglu, pg8::StaticOrder, true, true>(lds, g, S, E); SEAM(pb + 0); }
        if (IN(pb + 1)) { OPQ(); pg8::Gemm g{WSB(WS_HID), WL(O_WD1), TT, 2048, 5632}; pg8::StaticOrder S; S.init(TT, 2048, G_, bx_);
            pg8::EpiResid E{l == 0 ? args.in[0] : YP, l == 0 ? args.in[1] - (size_t)T_P * 2048 : YP, YP, WSB(WS_XB), SSP(3 * l + 1), 0.5f};
            pg8::gemm_phase<pg8::EpiResid, pg8::StaticOrder, true, true>(lds, g, S, E); SEAM(pb + 1); }
        if (IN(pb + 2)) { OPQ(); pg8::Gemm g{WSB(WS_XB), WL(O_WIN), TT, NPROJ, 2048}; pg8::StaticOrder S; S.init(TT, NPROJ, G_, bx_);
            pg8::EpiProj E{SSP(3 * l + 1), (const float*)(args.ws + WS_ROT), args.in[11] + l * 64, args.in[12] + l * 64, WSB(WS_RQ), WSB(WS_RK), WSB(WS_RV), WSB(WS_RG), WSB(WS_DQ), WSB(WS_DK), WSB(WS_DV), WSB(WS_GR), WSB(WS_GD),
                           args.out + OUT_KP + (size_t)l * T_P * 1024, args.out + OUT_VP + (size_t)l * T_P * 1024, args.out + OUT_KS + (size_t)l * T_S * 1024, args.out + OUT_VS + (size_t)l * T_S * 1024};
            pg8::gemm_phase<pg8::EpiProj, pg8::StaticOrder, true, true>(lds, g, S, E); SEAM(pb + 2); }
        if (IN(pb + 3) || IN(pb + 4)) {
            const float* lamp = (const float*)(args.ws + WS_LAM);
            mix::AttnP AP{WSB(WS_DQ), WSB(WS_DK), WSB(WS_DV), args.in[2] + (size_t)l * NB * PAST * 1024, args.in[3] + (size_t)l * NB * PAST * 1024,
                          args.out + OUT_KS + (size_t)l * T_S * 1024, args.out + OUT_VS + (size_t)l * T_S * 1024, WSB(WS_DO), (float*)(args.ws + WS_PART), args.in[25], args.in[17] + l * 128, __uint_as_float(__builtin_amdgcn_readfirstlane(__float_as_uint(lamp[2 * l]))), __uint_as_float(__builtin_amdgcn_readfirstlane(__float_as_uint(lamp[2 * l + 1])))};
            if (IN(pb + 3)) { OPQ();
              for (int rep = 0; rep < ((PROBE_DUP & 2) ? 2 : 1); ++rep) {
                for (int p = bx_; p < 1024; p += G_) { const int pp = p & 511, bh = pp >> 3, j = pp & 7;
                    mix::attn_unit<false>(lds, AP, bh >> 3, bh & 7, p < 512 ? 15 - j : j); }
                for (int s = bx_; s < 256; s += G_) mix::attn_unit<true>(lds, AP, s >> 5, (s >> 2) & 7, s & 3);
                mix::RetP RP{WSB(WS_RQ), WSB(WS_RK), WSB(WS_RV), WSB(WS_RG), WSB(WS_RO), args.in[4] + (size_t)l * 64 * 16384, args.out + OUT_RP + (size_t)l * 64 * 16384, args.out + OUT_RS + (size_t)l * 64 * 16384};
                for (int r = bx_; r < 128; r += G_) mix::ret_unit(lds, RP, r >= 64, (r & 63) >> 3, r & 7);
              }
                SEAM(pb + 3); }
            if (IN(pb + 4)) { OPQ(); for (int s = bx_; s < 64; s += G_) mix::attn_merge_unit(lds, AP, s >> 3, s & 7); SEAM(pb + 4); }
        }
        if (IN(pb + 5)) { OPQ(); pg8::StaticOrder S; S.init(TT, 2048, G_, bx_);
            { pg8::Gemm g{WSB(WS_RO), WL(O_WR), TT, 2048, 1024}; pg8::EpiGate<0> E{WSB(WS_GR), WSB(WS_MRG)}; pg8::gemm_phase<pg8::EpiGate<0>, pg8::StaticOrder, true, true>(lds, g, S, E); }
            { pg8::Gemm g{WSB(WS_DO), WL(O_WDU), TT, 2048, 1024}; pg8::EpiGate<1> E{WSB(WS_GD), WSB(WS_MRG)}; pg8::gemm_phase<pg8::EpiGate<1>, pg8::StaticOrder, true, true>(lds, g, S, E); }
            SEAM(pb + 5); }
        if (IN(pb + 6)) { OPQ(); pg8::Gemm g{WSB(WS_MRG), WL(O_WO), TT, 2048, 2048}; pg8::StaticOrder S; S.init(TT, 2048, G_, bx_);
            pg8::EpiResid E{YP, YP, YP, WSB(WS_XB), SSP(3 * l + 2), 1.0f}; pg8::gemm_phase<pg8::EpiResid, pg8::StaticOrder, true, true>(lds, g, S, E); SEAM(pb + 6); }
        if (IN(pb + 7)) { OPQ(); pg8::Gemm g{WSB(WS_XB), WL(O_WGU2), TT, NPROJ, 2048}; pg8::StaticOrder S; S.init(TT, NPROJ, G_, bx_);
            pg8::EpiSwiglu E{WSB(WS_HID), SSP(3 * l + 2)}; pg8::gemm_phase<pg8::EpiSwiglu, pg8::StaticOrder, true, true>(lds, g, S, E); SEAM(pb + 7); }
        if (IN(pb + 8)) { OPQ(); pg8::Gemm g{WSB(WS_HID), WL(O_WD2), TT, 2048, 5632}; pg8::StaticOrder S; S.init(TT, 2048, G_, bx_);
            pg8::EpiResid E{YP, YP, YP, WSB(WS_XB), SSP(3 * l + 3), 0.5f}; pg8::gemm_phase<pg8::EpiResid, pg8::StaticOrder, true, true>(lds, g, S, E); SEAM(pb + 8); }
    }
#undef IN
#undef SEAM
}

extern "C" void kernel_launch(void* const* d_in, const int* in_sizes, int n_in, void* d_out, int out_size, void* d_ws, size_t ws_size, hipStream_t stream) {
    static int grid = 0;
    if (grid == 0) {
        if (n_in != 26 || out_size != (int)OUT_END || ws_size < WS_END) { fprintf(stderr, "kernel_launch: unexpected shapes: n_in %d out %d ws %zu (need %zu)\n", n_in, out_size, ws_size, (size_t)WS_END); grid = -1; return; }
        int dev = 0, cus = 0, per_cu = 0;
        if (hipGetDevice(&dev) != hipSuccess || hipDeviceGetAttribute(&cus, hipDeviceAttributeMultiprocessorCount, dev) != hipSuccess) { grid = -1; return; }
        if (hipFuncSetAttribute((const void*)mk_fwd, hipFuncAttributeMaxDynamicSharedMemorySize, LDS_BYTES) != hipSuccess) { fprintf(stderr, "kernel_launch: hipFuncSetAttribute failed\n"); grid = -1; return; }
        if (hipOccupancyMaxActiveBlocksPerMultiprocessor(&per_cu, (const void*)mk_fwd, NWAVES * 64, LDS_BYTES) != hipSuccess || per_cu < 1) fprintf(stderr, "kernel_launch: occupancy query says %d\n", per_cu);
        (void)hipGetLastError();
        grid = cus;
    }
    if (grid < 0) return;
    (void)hipMemsetAsync((char*)d_ws + WS_CTL, 0, CTL_ZERO_BYTES, stream);
    Args a{};
    for (int i = 0; i < 26; ++i) a.in[i] = (const float*)d_in[i];
    a.out = (float*)d_out; a.ws = (unsigned char*)d_ws;
#if MK_PER_PHASE
    for (int p = 0; p < NPHASE; ++p) { a.ph_lo = p; a.ph_hi = p + 1; hipLaunchKernelGGL(mk_fwd, dim3(grid), dim3(NWAVES * 64), LDS_BYTES, stream, a); }
#else
    a.ph_lo = 0; a.ph_hi = NPHASE; hipLaunchKernelGGL(mk_fwd, dim3(grid), dim3(NWAVES * 64), LDS_BYTES, stream, a);
#endif
}
```
